# Optimizing an MI355X kernel written in HIP

```python
import jax, jax.numpy as jnp
from jax import lax
import numpy as np

D_MODEL = 1024
BATCH = 8
SEQ = 2048
DEPTH = 2

EPS = 1e-6
NEG_INF = -1e30
CONV_W = 3
CONV_CH = D_MODEL // 4
CONV_GROUPS = 4
DN_HEADS = 4
DN_HEAD_DIM = 128
DN_WIDTH = DN_HEADS * DN_HEAD_DIM
DN_CHUNK = 64
SWA_HEAD_DIM = 64
SWA_HEADS = 4
SWA_PATTERNS = ((128, 1), (512, 4), (2048, 16))
SWA_N_PAT = 3
SWA_WIDTH = SWA_HEADS * SWA_HEAD_DIM
SWA_QKV_WIDTH = SWA_N_PAT * SWA_WIDTH
SWA_BLOCK = 64
ROPE_THETA = 500000.0
ROPE_DIM = SWA_HEAD_DIM // 4
D_FF = 2816
MIX_WIDTH = CONV_CH + DN_WIDTH + SWA_WIDTH
IN_SIZES = (CONV_CH, CONV_CH, CONV_CH,
            DN_WIDTH, DN_WIDTH, DN_WIDTH, DN_WIDTH,
            DN_HEADS, DN_HEADS, DN_HEADS, DN_HEADS,
            SWA_QKV_WIDTH, SWA_QKV_WIDTH, SWA_QKV_WIDTH)
IN_WIDTH = sum(IN_SIZES)

kernel_name = 'hybrid_parallel_heads_encoder'


def rmsnorm(x, g):
    xf = x.astype(jnp.float32)
    y = xf * lax.rsqrt(jnp.mean(xf * xf, axis=-1, keepdims=True) + EPS)
    return (y * g.astype(jnp.float32)).astype(x.dtype)


def group_rmsnorm(x, g, n_groups):
    shp = x.shape
    xf = x.astype(jnp.float32).reshape(shp[:-1] + (n_groups, shp[-1] // n_groups))
    y = xf * lax.rsqrt(jnp.mean(xf * xf, axis=-1, keepdims=True) + EPS)
    return (y.reshape(shp) * g.astype(jnp.float32)).astype(x.dtype)


def dwconv3(x, w):
    xp = jnp.pad(x, ((0, 0), (1, 1), (0, 0)))
    return xp[:, :-2] * w[0] + xp[:, 1:-1] * w[1] + xp[:, 2:] * w[2]


def l2norm(x):
    return x * lax.rsqrt(jnp.sum(x * x, axis=-1, keepdims=True) + EPS)


def split_cols(a, sizes):
    idx = [int(i) for i in np.cumsum(sizes)[:-1]]
    return jnp.split(a, idx, axis=-1)


def short_conv_mixer(xa, gate_b, gate_c, w_conv):
    return gate_b * dwconv3(gate_c * xa, w_conv)


def gated_delta_chunked(q, k, v, g, beta):
    b, h, t, dk = q.shape
    dv = v.shape[-1]
    c = DN_CHUNK
    n = t // c

    def chunks(a):
        return a.reshape(a.shape[:2] + (n, c) + a.shape[3:])

    q, k, v, g, beta = (chunks(a) for a in (q, k, v, g, beta))
    g = jnp.cumsum(g, axis=-1)
    incl = jnp.tril(jnp.ones((c, c), dtype=bool))
    strict = jnp.tril(jnp.ones((c, c), dtype=bool), -1)
    diff = g[..., :, None] - g[..., None, :]
    decay = jnp.where(incl, jnp.exp(jnp.where(incl, diff, 0.0)), 0.0)
    kb = k * beta[..., None]
    a_mat = jnp.where(strict, jnp.einsum('bhncd,bhnsd->bhncs', kb, k) * decay, 0.0)
    t_mat = a_mat + jnp.eye(c, dtype=a_mat.dtype)
    rhs = jnp.concatenate([v * beta[..., None], kb * jnp.exp(g)[..., None]], axis=-1)
    sol = lax.linalg.triangular_solve(t_mat, rhs, left_side=True, lower=True, unit_diagonal=True)
    u, w = sol[..., :dv], sol[..., dv:]
    qk = jnp.where(incl, jnp.einsum('bhncd,bhnsd->bhncs', q, k) * decay, 0.0)
    q_dec = q * jnp.exp(g)[..., None]
    k_dec = k * jnp.exp(g[..., -1:] - g)[..., None]
    g_last = jnp.exp(g[..., -1])
    xs = tuple(jnp.moveaxis(a, 2, 0) for a in (u, w, qk, q_dec, k_dec, g_last))

    def step(state, inp):
        u_i, w_i, qk_i, qd_i, kd_i, gl_i = inp
        v_new = u_i - jnp.einsum('bhck,bhkv->bhcv', w_i, state)
        o_i = jnp.einsum('bhck,bhkv->bhcv', qd_i, state) + jnp.einsum('bhcs,bhsv->bhcv', qk_i, v_new)
        state = state * gl_i[..., None, None] + jnp.einsum('bhck,bhcv->bhkv', kd_i, v_new)
        return state, o_i

    s0 = jnp.zeros((b, h, dk, dv), jnp.float32)
    _, o = lax.scan(step, s0, xs)
    return jnp.moveaxis(o, 0, 2).reshape(b, h, t, dv)


def gated_deltanet_mixer(q, k, v, gate, b_f, b_b, a_f, a_b, w_conv,
                         a_log_f, a_log_b, dt_bias_f, dt_bias_b, norm_g):
    bsz, t, _ = q.shape
    qkv = jax.nn.silu(dwconv3(jnp.concatenate([q, k, v], axis=-1), w_conv)).astype(jnp.float32)
    q, k, v = jnp.split(qkv, 3, axis=-1)

    def heads(a):
        return a.reshape(bsz, t, DN_HEADS, DN_HEAD_DIM).transpose(0, 2, 1, 3)

    q = l2norm(heads(q)) * (DN_HEAD_DIM ** -0.5)
    k = l2norm(heads(k))
    v = heads(v)

    def decay_beta(a, bl, a_log, dt_bias):
        g = -jnp.exp(a_log.astype(jnp.float32)) * jax.nn.softplus(a.astype(jnp.float32) + dt_bias.astype(jnp.float32))
        beta = jax.nn.sigmoid(bl.astype(jnp.float32))
        return g.transpose(0, 2, 1), beta.transpose(0, 2, 1)

    g_f, beta_f = decay_beta(a_f, b_f, a_log_f, dt_bias_f)
    g_b, beta_b = decay_beta(a_b, b_b, a_log_b, dt_bias_b)
    flip = lambda a: jnp.flip(a, axis=2)
    o_f = gated_delta_chunked(q, k, v, g_f, beta_f)
    o_b = flip(gated_delta_chunked(flip(q), flip(k), flip(v), flip(g_b), flip(beta_b)))
    o = (o_f + o_b).transpose(0, 2, 1, 3)
    o = o * lax.rsqrt(jnp.mean(o * o, axis=-1, keepdims=True) + EPS) * norm_g.astype(jnp.float32)
    o = o * jax.nn.silu(gate.astype(jnp.float32).reshape(bsz, t, DN_HEADS, DN_HEAD_DIM))
    return o.reshape(bsz, t, DN_WIDTH).astype(gate.dtype)


def partial_rope(x, positions):
    half = ROPE_DIM // 2
    inv_freq = ROPE_THETA ** (-jnp.arange(half, dtype=jnp.float32) / half)
    ang = positions.astype(jnp.float32)[:, :, None] * inv_freq
    cos = jnp.cos(ang)[:, :, None, None, :]
    sin = jnp.sin(ang)[:, :, None, None, :]
    xr = x[..., :ROPE_DIM].astype(jnp.float32)
    x1, x2 = xr[..., :half], xr[..., half:]
    rot = jnp.concatenate([x1 * cos - x2 * sin, x2 * cos + x1 * sin], axis=-1).astype(x.dtype)
    return jnp.concatenate([rot, x[..., ROPE_DIM:]], axis=-1)


def banded_attention(q, k, v, radius):
    lead = q.shape[:-2]
    L, dh = q.shape[-2], q.shape[-1]
    blk = SWA_BLOCK
    nb = -(-L // blk)
    pad = nb * blk - L
    nlead = len(lead)
    qb = jnp.pad(q, [(0, 0)] * nlead + [(0, pad), (0, 0)]).reshape(lead + (nb, blk, dh))

    def windows(a):
        ap = jnp.pad(a, [(0, 0)] * nlead + [(blk, pad + blk), (0, 0)]).reshape(lead + (nb + 2, blk, dh))
        return jnp.concatenate([ap[..., :-2, :, :], ap[..., 1:-1, :, :], ap[..., 2:, :, :]], axis=-2)

    kw, vw = windows(k), windows(v)
    q_pos = jnp.arange(nb)[:, None] * blk + jnp.arange(blk)[None, :]
    k_pos = jnp.arange(nb)[:, None] * blk - blk + jnp.arange(3 * blk)[None, :]
    kp = k_pos[:, None, :]
    valid = (jnp.abs(q_pos[:, :, None] - kp) <= radius) & (kp >= 0) & (kp < L)
    s = jnp.einsum('...nqd,...nkd->...nqk', qb, kw).astype(jnp.float32) * (dh ** -0.5)
    s = jnp.where(valid, s, NEG_INF)
    m = jnp.max(s, axis=-1, keepdims=True)
    p = jnp.exp(s - m)
    den = jnp.sum(p, axis=-1, keepdims=True)
    o = jnp.einsum('...nqk,...nkd->...nqd', p / den, vw.astype(jnp.float32))
    lse = (m + jnp.log(den))[..., 0]
    o = o.reshape(lead + (nb * blk, dh))[..., :L, :]
    lse = lse.reshape(lead + (nb * blk,))[..., :L]
    return o, lse


def dilated_window_attention(q, k, v, positions):
    b, t, _ = q.shape
    shp = (b, t, SWA_N_PAT, SWA_HEADS, SWA_HEAD_DIM)
    q = partial_rope(q.reshape(shp), positions)
    k = partial_rope(k.reshape(shp), positions)
    v = v.reshape(shp)
    outs, lses = [], []
    for p_idx, (window, dil) in enumerate(SWA_PATTERNS):
        L = t // dil
        radius = window // (2 * dil)

        def to_sub(a):
            return a.reshape(b, L, dil, SWA_HEADS, SWA_HEAD_DIM).transpose(0, 3, 2, 1, 4)

        o, lse = banded_attention(to_sub(q[:, :, p_idx]), to_sub(k[:, :, p_idx]), to_sub(v[:, :, p_idx]), radius)
        outs.append(o.transpose(0, 3, 2, 1, 4).reshape(b, t, SWA_HEADS, SWA_HEAD_DIM))
        lses.append(lse.transpose(0, 3, 2, 1).reshape(b, t, SWA_HEADS))
    alpha = jax.nn.softmax(jnp.stack(lses, axis=0), axis=0)
    o = jnp.einsum('pbth,pbthd->bthd', alpha, jnp.stack(outs, axis=0))
    return o.reshape(b, t, SWA_WIDTH).astype(q.dtype)


def conv_gated_mlp(h, w_up, w_conv, w_down):
    u = dwconv3(h @ w_up, w_conv)
    gate, val = jnp.split(u, 2, axis=-1)
    return (jax.nn.silu(gate) * val) @ w_down


def setup_inputs(seed: int = 0) -> dict:
    key = jax.random.key(seed)
    ks = jax.random.split(key, 24)
    f32 = jnp.float32

    def nrm(k, shape, scale):
        return jax.random.normal(k, shape, f32) * scale

    def gain(k, shape):
        return 1.0 + 0.02 * jax.random.normal(k, shape, f32)

    def dt_bias(k):
        dt = jnp.exp(jax.random.uniform(k, (DEPTH, DN_HEADS), f32, np.log(1e-3), np.log(1e-1)))
        return dt + jnp.log(-jnp.expm1(-dt))

    x = nrm(ks[0], (BATCH, SEQ, D_MODEL), 1.0)
    positions = (jax.random.randint(ks[1], (BATCH, 1), 0, 4096, dtype=jnp.int32)
                 + jnp.arange(SEQ, dtype=jnp.int32)[None, :])
    return {
        'x': x,
        'positions': positions,
        'norm_mix': gain(ks[2], (DEPTH, D_MODEL)),
        'w_in': nrm(ks[3], (DEPTH, D_MODEL, IN_WIDTH), D_MODEL ** -0.5),
        'conv_a': nrm(ks[4], (DEPTH, CONV_W, CONV_CH), CONV_W ** -0.5),
        'norm_a': gain(ks[5], (DEPTH, CONV_CH)),
        'conv_qkv': nrm(ks[6], (DEPTH, CONV_W, 3 * DN_WIDTH), CONV_W ** -0.5),
        'a_log_f': jnp.log(jax.random.uniform(ks[7], (DEPTH, DN_HEADS), f32, 1.0, 16.0)),
        'a_log_b': jnp.log(jax.random.uniform(ks[8], (DEPTH, DN_HEADS), f32, 1.0, 16.0)),
        'dt_bias_f': dt_bias(ks[9]),
        'dt_bias_b': dt_bias(ks[10]),
        'norm_dn': gain(ks[11], (DEPTH, DN_HEAD_DIM)),
        'norm_c': gain(ks[12], (DEPTH, SWA_WIDTH)),
        'w_o': nrm(ks[13], (DEPTH, MIX_WIDTH, D_MODEL), MIX_WIDTH ** -0.5),
        'norm_ffn': gain(ks[14], (DEPTH, D_MODEL)),
        'w_up': nrm(ks[15], (DEPTH, D_MODEL, 2 * D_FF), D_MODEL ** -0.5),
        'conv_ffn': nrm(ks[16], (DEPTH, CONV_W, 2 * D_FF), CONV_W ** -0.5),
        'w_down': nrm(ks[17], (DEPTH, D_FF, D_MODEL), D_FF ** -0.5),
        'norm_final': gain(ks[18], (D_MODEL,)),
    }


def reference(x, positions, norm_mix, w_in, conv_a, norm_a, conv_qkv, a_log_f, a_log_b,
              dt_bias_f, dt_bias_b, norm_dn, norm_c, w_o, norm_ffn, w_up, conv_ffn, w_down,
              norm_final):
    for l in range(DEPTH):
        h = rmsnorm(x, norm_mix[l])
        proj = h @ w_in[l]
        (xa, gb, gc, q_dn, k_dn, v_dn, gate_dn, b_f, b_b, a_f, a_b,
         q_c, k_c, v_c) = split_cols(proj, IN_SIZES)
        y_a = group_rmsnorm(short_conv_mixer(xa, gb, gc, conv_a[l]), norm_a[l], CONV_GROUPS)
        y_b = gated_deltanet_mixer(q_dn, k_dn, v_dn, gate_dn, b_f, b_b, a_f, a_b, conv_qkv[l],
                                   a_log_f[l], a_log_b[l], dt_bias_f[l], dt_bias_b[l], norm_dn[l])
        y_c = group_rmsnorm(dilated_window_attention(q_c, k_c, v_c, positions), norm_c[l], SWA_HEADS)
        x = x + jnp.concatenate([y_a, y_b, y_c], axis=-1) @ w_o[l]
        x = x + conv_gated_mlp(rmsnorm(x, norm_ffn[l]), w_up[l], conv_ffn[l], w_down[l])
    return rmsnorm(x, norm_final)
```

```cpp
#include <hip/hip_runtime.h>
#include <hip/hip_cooperative_groups.h>
#include <cstdio>
#include <cstdint>
namespace cg = cooperative_groups;

#ifndef MEGA
#define MEGA 1
#endif

typedef unsigned short u16;
typedef short bf16x8 __attribute__((ext_vector_type(8)));
typedef float f32x4 __attribute__((ext_vector_type(4)));
typedef unsigned u32x4 __attribute__((ext_vector_type(4)));
typedef unsigned u32x2 __attribute__((ext_vector_type(2)));

constexpr int NT = 256;
constexpr int M_TOK = 16384, SEQ = 2048, DM = 1024;
constexpr int LDP = 5248;
constexpr int INW = 5136;
constexpr int DFF = 2816;
constexpr int C_QDN = 768, C_KDN = 1280, C_VDN = 1792, C_GATE = 2304, C_BF = 2816, C_BB = 2820, C_AF = 2824, C_AB = 2828;
constexpr int C_QC = 2832, C_KC = 3600, C_VC = 4368;
constexpr float EPS = 1e-6f;
constexpr int SMEM_BYTES = 73728;

struct Params {
  const float* x; const int* pos; const float* norm_mix; const float* w_in; const float* conv_a; const float* norm_a;
  const float* conv_qkv; const float* a_log_f; const float* a_log_b; const float* dt_bias_f; const float* dt_bias_b;
  const float* norm_dn; const float* norm_c; const float* w_o; const float* norm_ffn; const float* w_up; const float* conv_ffn;
  const float* w_down; const float* norm_final;
  float* xres;
  float* out;
  u16* proj;
  u16* inter;
  u16* WA; u16* WB; u16* halo; float* lse; float* gexp; float* rope;
  u16* ubnd;
  unsigned* bar;
};

__device__ __forceinline__ int obid() { int b = __builtin_amdgcn_workgroup_id_x(); asm volatile("" : "+s"(b)); return b; }
__device__ __forceinline__ int otid() { int t = __builtin_amdgcn_workitem_id_x(); asm volatile("" : "+v"(t)); return t; }
typedef float f32x2_t __attribute__((ext_vector_type(2)));
typedef __bf16 bf16x2_t __attribute__((ext_vector_type(2)));
__device__ __forceinline__ unsigned pk_bf16(float lo, float hi) {
  f32x2_t v = {lo, hi};
  bf16x2_t b = __builtin_convertvector(v, bf16x2_t);
  return __builtin_bit_cast(unsigned, b);
}
__device__ __forceinline__ u16 f2bf(float f) { return (u16)(pk_bf16(f, 0.f) & 0xffffu); }
__device__ __forceinline__ float bf2f(u16 h) { return __uint_as_float(((unsigned)h) << 16); }
__device__ __forceinline__ float bflo(unsigned w) { return __uint_as_float(w << 16); }
__device__ __forceinline__ float bfhi(unsigned w) { return __uint_as_float(w & 0xffff0000u); }
__device__ __forceinline__ float silu_f(float x) { return x / (1.f + __expf(-x)); }
__device__ __forceinline__ f32x4 mfma16(bf16x8 a, bf16x8 b, f32x4 c) { return __builtin_amdgcn_mfma_f32_16x16x32_bf16(a, b, c, 0, 0, 0); }
__device__ __forceinline__ bf16x8 ld8(const u16* p) { return *reinterpret_cast<const bf16x8*>(p); }
__device__ __forceinline__ u32x4 ldu4(const u16* p) { return *reinterpret_cast<const u32x4*>(p); }
__device__ __forceinline__ void unpack8(u32x4 w, float* f) {
  f[0] = bflo(w.x); f[1] = bfhi(w.x); f[2] = bflo(w.y); f[3] = bfhi(w.y);
  f[4] = bflo(w.z); f[5] = bfhi(w.z); f[6] = bflo(w.w); f[7] = bfhi(w.w);
}
__device__ __forceinline__ u32x4 pack8(const float* f) {
  u32x4 w; w.x = pk_bf16(f[0], f[1]); w.y = pk_bf16(f[2], f[3]); w.z = pk_bf16(f[4], f[5]); w.w = pk_bf16(f[6], f[7]); return w;
}

constexpr int EPI_PROJ = 0, EPI_RES = 1, EPI_BF16 = 2, EPI_UPACT = 3;
constexpr int GLD = 64;
constexpr int GBUF = 2 * 128 * GLD;

template <int EPI>
__device__ void gemm_phase(const u16* __restrict__ A, int lda, const u16* __restrict__ Bt, int Mrows, int N, int K,
                           u16* Cb, int ldc, float* Cres, const float* Rin, u16* halo, unsigned char* smem) {
  u16* As = (u16*)smem;
  u16* Bs = As + 128 * GLD;
  const int tid = otid(), lane = tid & 63, wid = tid >> 6, wr = wid >> 1, wc = wid & 1;
  const int fr = lane & 15, fq = lane >> 4;
  const int ntm = Mrows / 128, ntn = N / 128, ntiles = ntm * ntn;
  const int nk = K / 64;
  const int xcd = obid() & 7, jb = obid() >> 3, nper = gridDim.x >> 3, tmper = ntm >> 3;
  (void)ntiles;
  for (int q = jb; q < tmper * ntn; q += nper) {
    const int tm = xcd * tmper + (q % tmper), tn = q / tmper;
    const int m0 = tm * 128, n0 = tn * 128;
    f32x4 acc[4][4];
#pragma unroll
    for (int i = 0; i < 4; ++i)
#pragma unroll
      for (int j = 0; j < 4; ++j) acc[i][j] = (f32x4){0.f, 0.f, 0.f, 0.f};
    u32x4 ra0[4], rb0[4], ra1[4], rb1[4];
    const int lrow = tid >> 3, lch = tid & 7;
    const int swc = lch ^ (lrow & 7);
    const u16* Ag = A + (size_t)(m0 + lrow) * lda + lch * 8;
    const u16* Bg = Bt + (size_t)(n0 + lrow) * K + lch * 8;
#define G_LOAD(RA, RB, KT) do { const int ko_ = (KT) * 64; _Pragma("unroll") for (int i = 0; i < 4; ++i) { RA[i] = ldu4(Ag + (size_t)(i * 32) * lda + ko_); RB[i] = ldu4(Bg + (size_t)(i * 32) * K + ko_); } } while (0)
#define G_STORE(RA, RB, ST) do { u16* An_ = As + (ST) * GBUF; u16* Bn_ = Bs + (ST) * GBUF; _Pragma("unroll") for (int i = 0; i < 4; ++i) { \
      *reinterpret_cast<u32x4*>(An_ + (lrow + i * 32) * GLD + swc * 8) = RA[i]; *reinterpret_cast<u32x4*>(Bn_ + (lrow + i * 32) * GLD + swc * 8) = RB[i]; } } while (0)
#define G_COMPUTE(ST) do { const u16* Ac = As + (ST) * GBUF; const u16* Bc = Bs + (ST) * GBUF; _Pragma("unroll") for (int ks = 0; ks < 2; ++ks) { \
      bf16x8 af[4], bfr[4]; _Pragma("unroll") for (int i = 0; i < 4; ++i) { \
        af[i] = ld8(Ac + (wr * 64 + i * 16 + fr) * GLD + (((ks * 4 + fq) ^ (fr & 7)) * 8)); \
        bfr[i] = ld8(Bc + (wc * 64 + i * 16 + fr) * GLD + (((ks * 4 + fq) ^ (fr & 7)) * 8)); } \
      __builtin_amdgcn_s_setprio(1); \
      _Pragma("unroll") for (int mt = 0; mt < 4; ++mt) _Pragma("unroll") for (int nt = 0; nt < 4; ++nt) acc[mt][nt] = mfma16(bfr[nt], af[mt], acc[mt][nt]); \
      __builtin_amdgcn_s_setprio(0); } } while (0)
    G_LOAD(ra0, rb0, 0);
    G_LOAD(ra1, rb1, 1);
    __syncthreads();
    G_STORE(ra0, rb0, 0);
    __syncthreads();
    for (int kt = 0; kt < nk; kt += 2) {
      if (kt + 2 < nk) G_LOAD(ra0, rb0, kt + 2);
      G_COMPUTE(0);
      G_STORE(ra1, rb1, 1);
      __syncthreads();
      if (kt + 3 < nk) G_LOAD(ra1, rb1, kt + 3);
      G_COMPUTE(1);
      if (kt + 2 < nk) G_STORE(ra0, rb0, 0);
      __syncthreads();
    }
#undef G_LOAD
#undef G_STORE
#undef G_COMPUTE
    if (EPI == EPI_UPACT) {
      u16* T = (u16*)smem;
#pragma unroll
      for (int mt = 0; mt < 4; ++mt)
#pragma unroll
        for (int nt = 0; nt < 4; ++nt) {
          const f32x4 v = acc[mt][nt];
          u32x2 w; w.x = pk_bf16(v[0], v[1]); w.y = pk_bf16(v[2], v[3]);
          *reinterpret_cast<u32x2*>(T + (wr * 64 + mt * 16 + fr) * 136 + wc * 64 + nt * 16 + fq * 4) = w;
        }
      __syncthreads();
      const int jc = tid & 7, jg = tn * 64 + jc * 8;
      const float* cw = Rin;
      float wg[3][8], wv[3][8];
#pragma unroll
      for (int i = 0; i < 3; ++i)
#pragma unroll
        for (int e4 = 0; e4 < 2; ++e4) {
          const f32x4 a = *reinterpret_cast<const f32x4*>(cw + i * 2 * DFF + jg + e4 * 4), bq = *reinterpret_cast<const f32x4*>(cw + i * 2 * DFF + DFF + jg + e4 * 4);
#pragma unroll
          for (int e = 0; e < 4; ++e) { wg[i][e4 * 4 + e] = a[e]; wv[i][e4 * 4 + e] = bq[e]; }
        }
#pragma unroll 1
      for (int k = 0; k < 4; ++k) {
        const int t = (tid >> 3) + 32 * k;
        if (t >= 1 && t <= 126) {
          float g[8], vv[8];
#pragma unroll
          for (int e = 0; e < 8; ++e) { g[e] = 0.f; vv[e] = 0.f; }
#pragma unroll
          for (int i = 0; i < 3; ++i) {
            float a[8], bq[8];
            unpack8(*reinterpret_cast<const u32x4*>(T + (t + i - 1) * 136 + jc * 8), a);
            unpack8(*reinterpret_cast<const u32x4*>(T + (t + i - 1) * 136 + 64 + jc * 8), bq);
#pragma unroll
            for (int e = 0; e < 8; ++e) { g[e] += wg[i][e] * a[e]; vv[e] += wv[i][e] * bq[e]; }
          }
          float o[8];
#pragma unroll
          for (int e = 0; e < 8; ++e) o[e] = silu_f(g[e]) * vv[e];
          *reinterpret_cast<u32x4*>(Cb + (size_t)(m0 + t) * ldc + jg) = pack8(o);
        }
        if (t <= 1 || t >= 126) {
          const int slot = (t <= 1) ? t : t - 124;
          u16* ub = halo + (size_t)(tm * 4 + slot) * (2 * DFF) + n0;
          *reinterpret_cast<u32x4*>(ub + jc * 8) = *reinterpret_cast<const u32x4*>(T + t * 136 + jc * 8);
          *reinterpret_cast<u32x4*>(ub + 64 + jc * 8) = *reinterpret_cast<const u32x4*>(T + t * 136 + 64 + jc * 8);
        }
      }
      continue;
    }
    if (EPI == EPI_RES) {
      f32x4 r[4][4];
#pragma unroll
      for (int mt = 0; mt < 4; ++mt)
#pragma unroll
        for (int nt = 0; nt < 4; ++nt) r[mt][nt] = *reinterpret_cast<const f32x4*>(Rin + (size_t)(m0 + wr * 64 + mt * 16 + fr) * ldc + n0 + wc * 64 + nt * 16 + fq * 4);
#pragma unroll
      for (int mt = 0; mt < 4; ++mt)
#pragma unroll
        for (int nt = 0; nt < 4; ++nt) *reinterpret_cast<f32x4*>(Cres + (size_t)(m0 + wr * 64 + mt * 16 + fr) * ldc + n0 + wc * 64 + nt * 16 + fq * 4) = r[mt][nt] + acc[mt][nt];
      continue;
    }
#pragma unroll
    for (int mt = 0; mt < 4; ++mt) {
      const int m = m0 + wr * 64 + mt * 16 + fr;
#pragma unroll
      for (int nt = 0; nt < 4; ++nt) {
        const int n = n0 + wc * 64 + nt * 16 + fq * 4;
        const f32x4 v = acc[mt][nt];
        if (EPI == EPI_RES) {
          float* p = Cres + (size_t)m * ldc + n;
          f32x4 o = *reinterpret_cast<const f32x4*>(Rin + (size_t)m * ldc + n);
          o += v;
          *reinterpret_cast<f32x4*>(p) = o;
        } else {
          u32x2 w; w.x = pk_bf16(v[0], v[1]); w.y = pk_bf16(v[2], v[3]);
          *reinterpret_cast<u32x2*>(Cb + (size_t)m * ldc + n) = w;
          if (EPI == EPI_PROJ) {
            const int mm = m & 63;
            if ((mm == 0 || mm == 63) && n >= C_QDN && n < C_GATE)
              *reinterpret_cast<u32x2*>(halo + (size_t)((m >> 6) * 2 + (mm == 63 ? 1 : 0)) * 1536 + (n - C_QDN)) = w;
          }
        }
      }
    }
  }
}

template <int EPI>
__device__ void gemm256_phase(const u16* __restrict__ A, int lda, const u16* __restrict__ Bt, int Mrows, int N, int K,
                              u16* Cb, int ldc, float* Cres, const float* Rin, u16* halo, unsigned char* smem) {
  u16* As = (u16*)smem;
  u16* Bs = As + 256 * 64;
  const int tid = otid(), lane = tid & 63, wid = tid >> 6, wr = wid >> 1, wc = wid & 1;
  const int fr = lane & 15, fq = lane >> 4;
  const int ntm = Mrows / 256, ntn = N / 128, nk = K / 64;
  const int xcd = obid() & 7, jb = obid() >> 3, nper = gridDim.x >> 3, tmper = ntm >> 3;
  for (int q = jb; q < tmper * ntn; q += nper) {
    const int tm = xcd * tmper + (q % tmper), tn = q / tmper;
    const int m0 = tm * 256, n0 = tn * 128;
    f32x4 acc[8][4];
#pragma unroll
    for (int i = 0; i < 8; ++i)
#pragma unroll
      for (int j = 0; j < 4; ++j) acc[i][j] = (f32x4){0.f, 0.f, 0.f, 0.f};
    u32x4 ra[8], rb[4];
    const int lrow = tid >> 3, lch = tid & 7;
    const int swc = lch ^ (lrow & 7);
    const u16* Ag = A + (size_t)(m0 + lrow) * lda + lch * 8;
    const u16* Bg = Bt + (size_t)(n0 + lrow) * K + lch * 8;
#pragma unroll
    for (int i = 0; i < 8; ++i) ra[i] = ldu4(Ag + (size_t)(i * 32) * lda);
#pragma unroll
    for (int i = 0; i < 4; ++i) rb[i] = ldu4(Bg + (size_t)(i * 32) * K);
    for (int kt = 0; kt < nk; ++kt) {
      __syncthreads();
#pragma unroll
      for (int i = 0; i < 8; ++i) *reinterpret_cast<u32x4*>(As + (lrow + i * 32) * 64 + swc * 8) = ra[i];
#pragma unroll
      for (int i = 0; i < 4; ++i) *reinterpret_cast<u32x4*>(Bs + (lrow + i * 32) * 64 + swc * 8) = rb[i];
      if (kt + 1 < nk) {
        const int ko = (kt + 1) * 64;
#pragma unroll
        for (int i = 0; i < 8; ++i) ra[i] = ldu4(Ag + (size_t)(i * 32) * lda + ko);
#pragma unroll
        for (int i = 0; i < 4; ++i) rb[i] = ldu4(Bg + (size_t)(i * 32) * K + ko);
      }
      __syncthreads();
#pragma unroll
      for (int ks = 0; ks < 2; ++ks) {
        const int sw = ((ks * 4 + fq) ^ (fr & 7)) * 8;
        bf16x8 bfr[4];
#pragma unroll
        for (int i = 0; i < 4; ++i) bfr[i] = ld8(Bs + (wc * 64 + i * 16 + fr) * 64 + sw);
#pragma unroll
        for (int mh = 0; mh < 2; ++mh) {
          bf16x8 af[4];
#pragma unroll
          for (int i = 0; i < 4; ++i) af[i] = ld8(As + (wr * 128 + (mh * 4 + i) * 16 + fr) * 64 + sw);
          __builtin_amdgcn_s_setprio(1);
#pragma unroll
          for (int i = 0; i < 4; ++i)
#pragma unroll
            for (int nt = 0; nt < 4; ++nt) acc[mh * 4 + i][nt] = mfma16(bfr[nt], af[i], acc[mh * 4 + i][nt]);
          __builtin_amdgcn_s_setprio(0);
        }
      }
    }
    if (EPI == EPI_UPACT) {
      u16* T = (u16*)smem;
      __syncthreads();
#pragma unroll
      for (int mt = 0; mt < 8; ++mt)
#pragma unroll
        for (int nt = 0; nt < 4; ++nt) {
          const f32x4 v = acc[mt][nt];
          u32x2 w; w.x = pk_bf16(v[0], v[1]); w.y = pk_bf16(v[2], v[3]);
          *reinterpret_cast<u32x2*>(T + (wr * 128 + mt * 16 + fr) * 136 + wc * 64 + nt * 16 + fq * 4) = w;
        }
      __syncthreads();
      const int jc = tid & 7, jg = tn * 64 + jc * 8;
      const float* cw = Rin;
      float wg[3][8], wv[3][8];
#pragma unroll
      for (int i = 0; i < 3; ++i)
#pragma unroll
        for (int e4 = 0; e4 < 2; ++e4) {
          const f32x4 a = *reinterpret_cast<const f32x4*>(cw + i * 2 * DFF + jg + e4 * 4), bq = *reinterpret_cast<const f32x4*>(cw + i * 2 * DFF + DFF + jg + e4 * 4);
#pragma unroll
          for (int e = 0; e < 4; ++e) { wg[i][e4 * 4 + e] = a[e]; wv[i][e4 * 4 + e] = bq[e]; }
        }
#pragma unroll 1
      for (int k = 0; k < 8; ++k) {
        const int t = (tid >> 3) + 32 * k;
        if (t >= 1 && t <= 254) {
          float g[8], vv[8];
#pragma unroll
          for (int e = 0; e < 8; ++e) { g[e] = 0.f; vv[e] = 0.f; }
#pragma unroll
          for (int i = 0; i < 3; ++i) {
            float a[8], bq[8];
            unpack8(*reinterpret_cast<const u32x4*>(T + (t + i - 1) * 136 + jc * 8), a);
            unpack8(*reinterpret_cast<const u32x4*>(T + (t + i - 1) * 136 + 64 + jc * 8), bq);
#pragma unroll
            for (int e = 0; e < 8; ++e) { g[e] += wg[i][e] * a[e]; vv[e] += wv[i][e] * bq[e]; }
          }
          float o[8];
#pragma unroll
          for (int e = 0; e < 8; ++e) o[e] = silu_f(g[e]) * vv[e];
          *reinterpret_cast<u32x4*>(Cb + (size_t)(m0 + t) * ldc + jg) = pack8(o);
        }
        if (t <= 1 || t >= 254) {
          const int slot = (t <= 1) ? t : t - 252;
          u16* ub = halo + (size_t)(tm * 4 + slot) * (2 * DFF) + n0;
          *reinterpret_cast<u32x4*>(ub + jc * 8) = *reinterpret_cast<const u32x4*>(T + t * 136 + jc * 8);
          *reinterpret_cast<u32x4*>(ub + 64 + jc * 8) = *reinterpret_cast<const u32x4*>(T + t * 136 + 64 + jc * 8);
        }
      }
      continue;
    }
    if (EPI == EPI_RES) {
#pragma unroll
      for (int mh = 0; mh < 2; ++mh) {
        f32x4 r[4][4];
#pragma unroll
        for (int mt = 0; mt < 4; ++mt)
#pragma unroll
          for (int nt = 0; nt < 4; ++nt) r[mt][nt] = *reinterpret_cast<const f32x4*>(Rin + (size_t)(m0 + wr * 128 + (mh * 4 + mt) * 16 + fr) * ldc + n0 + wc * 64 + nt * 16 + fq * 4);
#pragma unroll
        for (int mt = 0; mt < 4; ++mt)
#pragma unroll
          for (int nt = 0; nt < 4; ++nt) *reinterpret_cast<f32x4*>(Cres + (size_t)(m0 + wr * 128 + (mh * 4 + mt) * 16 + fr) * ldc + n0 + wc * 64 + nt * 16 + fq * 4) = r[mt][nt] + acc[mh * 4 + mt][nt];
      }
      continue;
    }
#pragma unroll
    for (int mt = 0; mt < 8; ++mt) {
      const int m = m0 + wr * 128 + mt * 16 + fr;
#pragma unroll
      for (int nt = 0; nt < 4; ++nt) {
        const int n = n0 + wc * 64 + nt * 16 + fq * 4;
        const f32x4 v = acc[mt][nt];
        if (EPI == EPI_RES) {
          float* p = Cres + (size_t)m * ldc + n;
          f32x4 o = *reinterpret_cast<const f32x4*>(Rin + (size_t)m * ldc + n);
          o += v;
          *reinterpret_cast<f32x4*>(p) = o;
        } else {
          u32x2 w; w.x = pk_bf16(v[0], v[1]); w.y = pk_bf16(v[2], v[3]);
          *reinterpret_cast<u32x2*>(Cb + (size_t)m * ldc + n) = w;
          if (EPI == EPI_PROJ) {
            const int mm = m & 63;
            if ((mm == 0 || mm == 63) && n >= C_QDN && n < C_GATE)
              *reinterpret_cast<u32x2*>(halo + (size_t)((m >> 6) * 2 + (mm == 63 ? 1 : 0)) * 1536 + (n - C_QDN)) = w;
          }
        }
      }
    }
  }
}

__device__ void norm_task(const float* src, const float* __restrict__ g, u16* dst, float* dstf, int task) {
  const int lane = otid() & 63, wid = otid() >> 6;
#pragma unroll 1
  for (int rr = 0; rr < 4; ++rr) {
    const int row = task * 16 + wid * 4 + rr;
    const float* s = src + (size_t)row * DM;
    f32x4 v[4]; float ss = 0.f;
#pragma unroll
    for (int i = 0; i < 4; ++i) { v[i] = *reinterpret_cast<const f32x4*>(s + i * 256 + lane * 4); ss += v[i][0] * v[i][0] + v[i][1] * v[i][1] + v[i][2] * v[i][2] + v[i][3] * v[i][3]; }
#pragma unroll
    for (int o = 1; o < 64; o <<= 1) ss += __shfl_xor(ss, o);
    const float rs = rsqrtf(ss * (1.f / DM) + EPS);
#pragma unroll
    for (int i = 0; i < 4; ++i) {
      const f32x4 gg = *reinterpret_cast<const f32x4*>(g + i * 256 + lane * 4);
      f32x4 y; y[0] = v[i][0] * rs * gg[0]; y[1] = v[i][1] * rs * gg[1]; y[2] = v[i][2] * rs * gg[2]; y[3] = v[i][3] * rs * gg[3];
      if (dstf) *reinterpret_cast<f32x4*>(dstf + (size_t)row * DM + i * 256 + lane * 4) = y;
      else { u32x2 w; w.x = pk_bf16(y[0], y[1]); w.y = pk_bf16(y[2], y[3]); *reinterpret_cast<u32x2*>(dst + (size_t)row * DM + i * 256 + lane * 4) = w; }
    }
  }
}

__device__ void wconv_task(const float* __restrict__ W, int K, int N, int Npad, u16* Wt, int task, unsigned char* smem, bool perm = false) {
  float* tl = (float*)smem;
  const int ntn = Npad / 64;
  const int tk = task / ntn, tn = task % ntn;
  const int k0 = tk * 64, n0 = tn * 64, tid = otid();
  __syncthreads();
#pragma unroll
  for (int i = 0; i < 4; ++i) {
    const int k = (tid >> 4) + 16 * i, n4 = (tid & 15) * 4;
    f32x4 v = (f32x4){0.f, 0.f, 0.f, 0.f};
    if (n0 + n4 < N) v = *reinterpret_cast<const f32x4*>(W + (size_t)(k0 + k) * N + n0 + n4);
    tl[k * 65 + n4 + 0] = v[0]; tl[k * 65 + n4 + 1] = v[1]; tl[k * 65 + n4 + 2] = v[2]; tl[k * 65 + n4 + 3] = v[3];
  }
  __syncthreads();
  const int n = tid >> 2, ks = (tid & 3) * 16;
  float f[16];
#pragma unroll
  for (int i = 0; i < 16; ++i) f[i] = tl[(ks + i) * 65 + n];
  const int dn0 = perm ? (n0 < DFF ? (n0 >> 6) * 128 : ((n0 - DFF) >> 6) * 128 + 64) : n0;
  u16* o = Wt + (size_t)(dn0 + n) * K + k0 + ks;
  *reinterpret_cast<u32x4*>(o) = pack8(f);
  *reinterpret_cast<u32x4*>(o + 8) = pack8(f + 8);
}

__device__ void phase_norm_w(const Params& p, int l, int mode, int half, bool with_w, unsigned char* smem) {
  const int n_norm = (mode == 0 ? 8192 : M_TOK) / 16;
  int nA = 0, nB = 0;
  if (with_w) {
    if (mode == 0) { nA = (l == 0) ? (DM / 64) * (LDP / 64) : 0; nB = 0; }
    else { nA = 0; nB = (DFF / 64) * (DM / 64); }
  }
  const int n_rope = (with_w && mode == 0 && l == 0) ? (M_TOK * 8 / NT) : 0;
  const int total = n_norm + nA + nB + n_rope;
  u16* h = p.inter;
  const float* xsrc = (l == 0 && mode == 0) ? p.x : p.xres;
  for (int t = obid(); t < total; t += gridDim.x) {
    if (t < n_norm) {
      if (mode == 0) norm_task(xsrc + (size_t)half * 8192 * DM, p.norm_mix + l * DM, h, nullptr, t);
      else norm_task(p.xres, p.norm_ffn + l * DM, h, nullptr, t);
    } else if (t < n_norm + nA) {
      if (mode == 0) wconv_task(p.w_in + (size_t)l * DM * INW, DM, INW, LDP, p.WA, t - n_norm, smem);
      else wconv_task(p.w_up + (size_t)l * DM * 2 * DFF, DM, 2 * DFF, 2 * DFF, p.WA, t - n_norm, smem, true);
    } else if (t < n_norm + nA + nB) {
      if (mode == 0) wconv_task(p.w_o + (size_t)l * DM * DM, DM, DM, DM, p.WB, t - n_norm - nA, smem);
      else wconv_task(p.w_down + (size_t)l * DFF * DM, DFF, DM, DM, p.WB, t - n_norm - nA, smem);
    } else {
      const int idx = (t - n_norm - nA - nB) * NT + otid();
      const int tok = idx >> 3, i = idx & 7;
      const float invf[8] = {1.0f, 0.1939227432012558f, 0.03760603070259094f, 0.007292664609849453f, 0.0014142135623842478f,
                             0.00027424818836152554f, 5.318296098266728e-05f, 1.0313386155758053e-05f};
      float fr = invf[0];
#pragma unroll
      for (int q = 1; q < 8; ++q) fr = (i == q) ? invf[q] : fr;
      const float ang = (float)p.pos[tok] * fr;
      const float kq = rintf(ang * 0.15915494309189535f);
      float rr = fmaf(-kq, 6.2831854820251465f, ang); rr = fmaf(-kq, -1.7484555314695172e-07f, rr);
      float sn, cs; sn = __sinf(rr); cs = __cosf(rr);
      p.rope[tok * 16 + i] = cs; p.rope[tok * 16 + 8 + i] = sn;
    }
  }
}

__device__ __forceinline__ float softplus_f(float x) { return fmaxf(x, 0.f) + log1pf(__expf(-fabsf(x))); }

__device__ void dn_local_task(const Params& p, int l, int task, unsigned char* smem) {
  const int b = task >> 7, h = (task >> 5) & 3, n = task & 31;
  int tid_ = otid();
  const int tid = tid_, lane = tid & 63, wid = tid >> 6;
  const size_t rowbase = (size_t)b * SEQ + n * 64;
  u16* qn_s = (u16*)smem;
  u16* kn_s = qn_s + 64 * 136;
  u16* v_s = kn_s + 64 * 136;
  float* A_f = (float*)(smem + 52224);
  float* A_b = (float*)smem;
  float* sm = (float*)(smem + 68608);
  float* gcs = sm; float* bts = sm + 128;
  __syncthreads();
  {
    const size_t chunk_id = (size_t)b * 32 + n;
    const int ch = tid & 15, r0 = tid >> 4;
#pragma unroll
    for (int part = 0; part < 3; ++part) {
      const int hc = part * 512 + h * 128 + ch * 8;
      const float* cw = p.conv_qkv + (size_t)l * 3 * 1536 + hc;
      u32x4 xm[4], x0[4], xp[4];
#pragma unroll
      for (int k = 0; k < 4; ++k) {
        const int r = k * 16 + r0;
        const u16* pc = p.proj + (rowbase + r) * LDP + C_QDN + hc;
        const u16* pm = (r == 0) ? (n == 0 ? pc : p.halo + ((chunk_id - 1) * 2 + 1) * 1536 + hc) : pc - LDP;
        const u16* pp = (r == 63) ? (n == 31 ? pc : p.halo + ((chunk_id + 1) * 2 + 0) * 1536 + hc) : pc + LDP;
        xm[k] = ldu4(pm); x0[k] = ldu4(pc); xp[k] = ldu4(pp);
      }
      float w0[8], w1[8], w2[8];
#pragma unroll
      for (int e4 = 0; e4 < 2; ++e4) {
        const f32x4 a0 = *reinterpret_cast<const f32x4*>(cw + e4 * 4), a1 = *reinterpret_cast<const f32x4*>(cw + 1536 + e4 * 4), a2 = *reinterpret_cast<const f32x4*>(cw + 3072 + e4 * 4);
#pragma unroll
        for (int e = 0; e < 4; ++e) { w0[e4 * 4 + e] = a0[e]; w1[e4 * 4 + e] = a1[e]; w2[e4 * 4 + e] = a2[e]; }
      }
      u16* dbase = (part == 0 ? qn_s : (part == 1 ? kn_s : v_s)) + ch * 8;
#pragma unroll
      for (int k = 0; k < 4; ++k) {
        const int r = k * 16 + r0;
        const float mz = (r == 0 && n == 0) ? 0.f : 1.f, pz = (r == 63 && n == 31) ? 0.f : 1.f;
        float fm[8], f0[8], fp[8], o[8];
        unpack8(xm[k], fm); unpack8(x0[k], f0); unpack8(xp[k], fp);
        float ss = 0.f;
#pragma unroll
        for (int e = 0; e < 8; ++e) {
          float a = w1[e] * f0[e] + mz * (w0[e] * fm[e]) + pz * (w2[e] * fp[e]);
          a = silu_f(a);
          o[e] = a; ss += a * a;
        }
        ss += __shfl_xor(ss, 1); ss += __shfl_xor(ss, 2); ss += __shfl_xor(ss, 4); ss += __shfl_xor(ss, 8);
        float sc = 1.f;
        if (part == 0) sc = rsqrtf(ss + EPS) * 0.08838834764831845f;
        else if (part == 1) sc = rsqrtf(ss + EPS);
#pragma unroll
        for (int e = 0; e < 8; ++e) o[e] *= sc;
        *reinterpret_cast<u32x4*>(dbase + r * 136) = pack8(o);
      }
    }
  }
  if (wid < 2) {
    const int dir = wid;
    const int c = dir ? 63 - lane : lane;
    const u16* rp = p.proj + (rowbase + c) * LDP;
    const float a = bf2f(rp[(dir ? C_AB : C_AF) + h]);
    const float bl = bf2f(rp[(dir ? C_BB : C_BF) + h]);
    const float alog = dir ? p.a_log_b[l * 4 + h] : p.a_log_f[l * 4 + h];
    const float dtb = dir ? p.dt_bias_b[l * 4 + h] : p.dt_bias_f[l * 4 + h];
    float g = -__expf(alog) * softplus_f(a + dtb);
    const float beta = 1.f / (1.f + __expf(-bl));
#pragma unroll
    for (int o = 1; o < 64; o <<= 1) { const float t = __shfl_up(g, o); if (lane >= o) g += t; }
    gcs[dir * 64 + lane] = g; bts[dir * 64 + lane] = beta; sm[256 + dir * 64 + lane] = beta * __expf(g);
    const float glast = __shfl(g, 63);
    float* ge = p.gexp + ((((size_t)b * 4 + h) * 2 + dir) * 32 + n) * 192;
    ge[lane] = __expf(g); ge[64 + lane] = __expf(glast - g);
    if (lane == 0) ge[128] = __expf(glast);
  }
  __syncthreads();
  {
#pragma unroll
    for (int it = 0; it < 4; ++it) {
      const int q = tid + 256 * it, r = q >> 4, ch = q & 15;
      *reinterpret_cast<u32x4*>(p.proj + (rowbase + r) * LDP + C_QDN + h * 128 + ch * 8) = *reinterpret_cast<const u32x4*>(qn_s + r * 136 + ch * 8);
    }
#pragma unroll
    for (int it = 0; it < 4; ++it) {
      const int q = tid + 256 * it, kk = q >> 3, c0 = (q & 7) * 8;
      float f[8];
#pragma unroll
      for (int e = 0; e < 8; ++e) f[e] = bf2f(kn_s[(c0 + e) * 136 + kk]);
      *reinterpret_cast<u32x4*>(p.proj + (rowbase + (kk >> 1)) * LDP + C_KDN + h * 128 + (kk & 1) * 64 + c0) = pack8(f);
    }
  }
  const int fr = lane & 15, fq = lane >> 4;
  f32x4 kk[4], qk[4];
#pragma unroll
  for (int jt = 0; jt < 4; ++jt) { kk[jt] = (f32x4){0.f, 0.f, 0.f, 0.f}; qk[jt] = (f32x4){0.f, 0.f, 0.f, 0.f}; }
#pragma unroll
  for (int ks = 0; ks < 4; ++ks) {
    const bf16x8 bk = ld8(kn_s + (16 * wid + fr) * 136 + ks * 32 + fq * 8);
    const bf16x8 bq = ld8(qn_s + (16 * wid + fr) * 136 + ks * 32 + fq * 8);
#pragma unroll
    for (int jt = 0; jt < 4; ++jt) {
      const bf16x8 a = ld8(kn_s + (16 * jt + fr) * 136 + ks * 32 + fq * 8);
      kk[jt] = mfma16(a, bk, kk[jt]);
      qk[jt] = mfma16(a, bq, qk[jt]);
    }
  }
  __syncthreads();
  u16* blk = p.inter + (size_t)task * 32768;
  {
    const int i = 16 * wid + fr, ib = 63 - i;
    const float gfi = gcs[i], gbi = gcs[64 + ib], bfi = bts[i], bbi = bts[64 + ib];
#pragma unroll
    for (int jt = 0; jt < 4; ++jt) {
      const int j0 = 16 * jt + fq * 4;
      f32x4 af, ab, qf, qb;
#pragma unroll
      for (int e = 0; e < 4; ++e) {
        const int j = j0 + e, jb = 63 - j;
        const float df = (i >= j) ? __expf(gfi - gcs[j]) : 0.f;
        const float db = (ib >= jb) ? __expf(gbi - gcs[64 + jb]) : 0.f;
        af[e] = (i > j) ? bfi * kk[jt][e] * df : 0.f;
        qf[e] = qk[jt][e] * df;
        ab[3 - e] = (ib > jb) ? bbi * kk[jt][e] * db : 0.f;
        qb[3 - e] = qk[jt][e] * db;
      }
      *reinterpret_cast<f32x4*>(A_f + i * 64 + j0) = af;
      *reinterpret_cast<f32x4*>(A_b + ib * 64 + (60 - j0)) = ab;
      u32x2 w; w.x = pk_bf16(qf[0], qf[1]); w.y = pk_bf16(qf[2], qf[3]);
      *reinterpret_cast<u32x2*>(blk + 24576 + i * 64 + j0) = w;
      w.x = pk_bf16(qb[0], qb[1]); w.y = pk_bf16(qb[2], qb[3]);
      *reinterpret_cast<u32x2*>(blk + 28672 + ib * 64 + (60 - j0)) = w;
    }
  }
  __syncthreads();
#ifndef NOSOLVE
  {
    const int col = tid & 127; const bool isW = tid >= 128;
    const u16* src = (isW ? kn_s : v_s) + col;
    const float* scb = isW ? (sm + 256) : bts;
#pragma unroll 1
    for (int dir = 0; dir < 2; ++dir) {
      int dsel = dir; asm volatile("" : "+v"(dsel));
      const float* Am = (const float*)(smem + (dsel ? 0 : 52224));
      const float* scp = scb + dsel * 64;
      const u16* sp = src + (dsel ? 63 * 136 : 0);
      const int sstride = dsel ? -136 : 136;
      u16* dstW = blk + (dsel ? 16384 : 0) + col;
      u16* dstU = dsel ? (blk + 8192 + col) : (p.proj + rowbase * LDP + C_VDN + h * 128 + col);
      u16* dst = isW ? dstW : dstU;
      const int ld = (isW || dsel) ? 128 : LDP;
      float x[64];
      const float* Al = Am + (tid & 63);
      float arow_n = Al[64];
#pragma unroll
      for (int i = 0; i < 64; ++i) {
        float a0 = scp[i] * bf2f(*sp), a1 = 0.f, a2 = 0.f, a3 = 0.f;
        sp += sstride;
        const int arow = __float_as_int(arow_n);
        if (i + 1 < 64 && i >= 1) arow_n = Al[(i + 1) * 64];
#pragma unroll
        for (int j = 0; j < i; ++j) {
          int stmp;
          if ((j & 3) == 0) asm volatile("v_readlane_b32 %1, %2, %3\n\tv_fma_f32 %0, -%1, %4, %0" : "+v"(a0), "=&s"(stmp) : "v"(arow), "n"(j), "v"(x[j]));
          else if ((j & 3) == 1) asm volatile("v_readlane_b32 %1, %2, %3\n\tv_fma_f32 %0, -%1, %4, %0" : "+v"(a1), "=&s"(stmp) : "v"(arow), "n"(j), "v"(x[j]));
          else if ((j & 3) == 2) asm volatile("v_readlane_b32 %1, %2, %3\n\tv_fma_f32 %0, -%1, %4, %0" : "+v"(a2), "=&s"(stmp) : "v"(arow), "n"(j), "v"(x[j]));
          else asm volatile("v_readlane_b32 %1, %2, %3\n\tv_fma_f32 %0, -%1, %4, %0" : "+v"(a3), "=&s"(stmp) : "v"(arow), "n"(j), "v"(x[j]));
        }
        x[i] = (a0 + a1) + (a2 + a3);
      }
#pragma unroll
      for (int i = 0; i < 64; ++i) { *dst = f2bf(x[i]); dst += ld; }
    }
  }
#endif
}

struct ScanA { bf16x8 w[4]; u16 u[2][4]; float egl[4]; };
struct ScanB { bf16x8 qn[4], qk[2], kt[2][2]; float eg, gl; };

__device__ __forceinline__ void scan_loadA(const Params& p, int b, int h, int dir, int slice, int s, int wid, int lane, ScanA& L) {
  const int n = dir ? 31 - s : s;
  const int fr = lane & 15, fq = lane >> 4;
  const size_t rowbase = (size_t)b * SEQ + n * 64;
  const u16* blk = p.inter + ((size_t)(b * 4 + h) * 32 + n) * 32768;
  const int cp = 16 * wid + fr;
  const u16* Wp = blk + (dir ? 16384 : 0) + cp * 128 + fq * 8;
#pragma unroll
  for (int ks = 0; ks < 4; ++ks) L.w[ks] = ld8(Wp + ks * 32);
  const float* ge = p.gexp + ((((size_t)b * 4 + h) * 2 + dir) * 32 + n) * 192;
#pragma unroll
  for (int j = 0; j < 4; ++j) L.egl[j] = ge[64 + 16 * wid + fq * 4 + j];
#pragma unroll
  for (int nt = 0; nt < 2; ++nt)
#pragma unroll
    for (int j = 0; j < 4; ++j) {
      const int c2 = 16 * wid + fq * 4 + j, col = slice * 32 + nt * 16 + fr;
      L.u[nt][j] = dir ? blk[8192 + c2 * 128 + col] : p.proj[(rowbase + c2) * LDP + C_VDN + h * 128 + col];
    }
}
__device__ __forceinline__ void scan_loadB(const Params& p, int b, int h, int dir, int s, int wid, int lane, ScanB& L) {
  const int n = dir ? 31 - s : s;
  const int fr = lane & 15, fq = lane >> 4;
  const size_t rowbase = (size_t)b * SEQ + n * 64;
  const u16* blk = p.inter + ((size_t)(b * 4 + h) * 32 + n) * 32768;
  const int cp = 16 * wid + fr;
  const int corig = dir ? 63 - cp : cp;
  const u16* Qp = p.proj + (rowbase + corig) * LDP + C_QDN + h * 128 + fq * 8;
  const u16* QKp = blk + (dir ? 28672 : 24576) + cp * 64 + fq * 8;
#pragma unroll
  for (int ks = 0; ks < 4; ++ks) L.qn[ks] = ld8(Qp + ks * 32);
#pragma unroll
  for (int ks = 0; ks < 2; ++ks) L.qk[ks] = ld8(QKp + ks * 32);
#pragma unroll
  for (int t = 0; t < 2; ++t) {
    const int kk = (2 * wid + t) * 16 + fr;
    const u16* Kp = p.proj + (rowbase + (kk >> 1)) * LDP + C_KDN + h * 128 + (kk & 1) * 64 + fq * 8;
#pragma unroll
    for (int ks = 0; ks < 2; ++ks) L.kt[t][ks] = ld8(Kp + ks * 32);
  }
  const float* ge = p.gexp + ((((size_t)b * 4 + h) * 2 + dir) * 32 + n) * 192;
  L.eg = ge[cp];
  L.gl = ge[128];
}

__device__ __forceinline__ void scan_step(const Params& p, int b, int h, int dir, int slice, int s, int wid, int lane,
                                          u16* ST0, u16* vnT, u16* vnsT, f32x4 (&S)[2][2],
                                          const ScanA& cur, const ScanB& cb, ScanA& nxt, ScanB& cbn) {
  const int fr = lane & 15, fq = lane >> 4;
  if (s + 1 < 32) { scan_loadA(p, b, h, dir, slice, s + 1, wid, lane, nxt); scan_loadB(p, b, h, dir, s + 1, wid, lane, cbn); }
  const u16* STc = ST0 + (s & 1) * 32 * 136;
  u16* STn = ST0 + ((s + 1) & 1) * 32 * 136;
  const int n = dir ? 31 - s : s;
  const size_t rowbase = (size_t)b * SEQ + n * 64;
  f32x4 vn[2];
#pragma unroll
  for (int nt = 0; nt < 2; ++nt) {
    f32x4 acc = (f32x4){0.f, 0.f, 0.f, 0.f};
#pragma unroll
    for (int ks = 0; ks < 4; ++ks) acc = mfma16(cur.w[ks], ld8(STc + (nt * 16 + fr) * 136 + ks * 32 + fq * 8), acc);
#pragma unroll
    for (int j = 0; j < 4; ++j) vn[nt][j] = bf2f(cur.u[nt][j]) - acc[j];
  }
#pragma unroll
  for (int nt = 0; nt < 2; ++nt) {
    const int nn = nt * 16 + fr, c0 = 16 * wid + fq * 4;
    u32x2 w; w.x = pk_bf16(vn[nt][0], vn[nt][1]); w.y = pk_bf16(vn[nt][2], vn[nt][3]);
    *reinterpret_cast<u32x2*>(vnT + nn * 72 + c0) = w;
    const float s0 = vn[nt][0] * cur.egl[0], s1 = vn[nt][1] * cur.egl[1], s2 = vn[nt][2] * cur.egl[2], s3 = vn[nt][3] * cur.egl[3];
    if (dir) { w.x = pk_bf16(s3, s2); w.y = pk_bf16(s1, s0); *reinterpret_cast<u32x2*>(vnsT + nn * 72 + (60 - c0)) = w; }
    else { w.x = pk_bf16(s0, s1); w.y = pk_bf16(s2, s3); *reinterpret_cast<u32x2*>(vnsT + nn * 72 + c0) = w; }
  }
  __syncthreads();
#pragma unroll
  for (int nt = 0; nt < 2; ++nt) {
    f32x4 a1 = (f32x4){0.f, 0.f, 0.f, 0.f}, a2 = (f32x4){0.f, 0.f, 0.f, 0.f};
#pragma unroll
    for (int ks = 0; ks < 4; ++ks) a1 = mfma16(ld8(STc + (nt * 16 + fr) * 136 + ks * 32 + fq * 8), cb.qn[ks], a1);
#pragma unroll
    for (int ks = 0; ks < 2; ++ks) a2 = mfma16(ld8(vnT + (nt * 16 + fr) * 72 + ks * 32 + fq * 8), cb.qk[ks], a2);
    const int cp = 16 * wid + fr, col = slice * 32 + nt * 16 + fq * 4;
    u32x2 w; w.x = pk_bf16(a1[0] * cb.eg + a2[0], a1[1] * cb.eg + a2[1]); w.y = pk_bf16(a1[2] * cb.eg + a2[2], a1[3] * cb.eg + a2[3]);
    u16* op = dir ? (p.inter + ((size_t)(b * 4 + h) * 32 + n) * 32768 + 8192 + cp * 128 + col)
                  : (p.proj + (rowbase + cp) * LDP + C_VDN + h * 128 + col);
    *reinterpret_cast<u32x2*>(op) = w;
  }
#pragma unroll
  for (int t = 0; t < 2; ++t)
#pragma unroll
    for (int nt = 0; nt < 2; ++nt) {
      f32x4 acc = S[t][nt] * cb.gl;
#pragma unroll
      for (int ks = 0; ks < 2; ++ks) acc = mfma16(cb.kt[t][ks], ld8(vnsT + (nt * 16 + fr) * 72 + ks * 32 + fq * 8), acc);
      S[t][nt] = acc;
      u32x2 w; w.x = pk_bf16(acc[0], acc[1]); w.y = pk_bf16(acc[2], acc[3]);
      *reinterpret_cast<u32x2*>(STn + (nt * 16 + fr) * 136 + (2 * wid + t) * 16 + fq * 4) = w;
    }
  __syncthreads();
}

__device__ void scan_task(const Params& p, int sid, unsigned char* smem) {
  const int b = sid >> 5, h = (sid >> 3) & 3, dir = (sid >> 2) & 1, slice = sid & 3;
  int tid_ = otid();
  const int tid = tid_, lane = tid & 63, wid = tid >> 6;
  u16* ST0 = (u16*)smem;
  u16* vnT = ST0 + 2 * 32 * 136;
  u16* vnsT = vnT + 32 * 72;
  __syncthreads();
  for (int i = tid; i < 32 * 136 / 2; i += NT) reinterpret_cast<unsigned*>(ST0)[i] = 0u;
  f32x4 S[2][2];
#pragma unroll
  for (int a = 0; a < 2; ++a)
#pragma unroll
    for (int c = 0; c < 2; ++c) S[a][c] = (f32x4){0.f, 0.f, 0.f, 0.f};
  ScanA a0, a1;
  ScanB b0, b1;
  scan_loadA(p, b, h, dir, slice, 0, wid, lane, a0);
  scan_loadB(p, b, h, dir, 0, wid, lane, b0);
  __syncthreads();
#pragma unroll 1
  for (int s = 0; s < 32; s += 2) {
    scan_step(p, b, h, dir, slice, s, wid, lane, ST0, vnT, vnsT, S, a0, b0, a1, b1);
    scan_step(p, b, h, dir, slice, s + 1, wid, lane, ST0, vnT, vnsT, S, a1, b1, a0, b0);
  }
}

__device__ void attn_task(const Params& p, int aid, int half, unsigned char* smem) {
  const int b = aid / 384, rem = aid % 384, pt = rem >> 7, rem2 = rem & 127, h = rem2 >> 5, q = rem2 & 31;
  const int dl = pt == 0 ? 1 : (pt == 1 ? 4 : 16);
  const int L = SEQ / dl, nbl = L / 64;
  const int r = q / nbl, nb = q % nbl;
  int tid_ = otid();
  const int tid = tid_, lane = tid & 63, wid = tid >> 6, fr = lane & 15, fq = lane >> 4;
  u16* Qs = (u16*)smem;
  u16* Ks = Qs + 64 * 72;
  u16* VT = Ks + 192 * 72;
  u16* Ps = Ks;
  const size_t tokbase = (size_t)b * SEQ;
  const int cq = C_QC + pt * 256 + h * 64, ck = C_KC + pt * 256 + h * 64, cv = C_VC + pt * 256 + h * 64;
  __syncthreads();
  {
    const int ch = tid & 7, rb = tid >> 3;
    u32x4 qk[8], vv[6];
#pragma unroll
    for (int k = 0; k < 8; ++k) {
      const int row = rb + 32 * k;
      const int i = (k < 2) ? nb * 64 + row : nb * 64 - 128 + row;
      qk[k] = (u32x4){0u, 0u, 0u, 0u};
      if (i >= 0 && i < L) qk[k] = ldu4(p.proj + (tokbase + (size_t)i * dl + r) * LDP + ((k < 2) ? cq : ck) + ch * 8);
    }
#pragma unroll
    for (int k = 0; k < 6; ++k) {
      const int j = nb * 64 - 64 + rb + 32 * k;
      vv[k] = (u32x4){0u, 0u, 0u, 0u};
      if (j >= 0 && j < L) vv[k] = ldu4(p.proj + (tokbase + (size_t)j * dl + r) * LDP + cv + ch * 8);
    }
#pragma unroll
    for (int k = 0; k < 8; ++k) {
      const int row = rb + 32 * k;
      u16* dst = ((k < 2) ? Qs + row * 72 : Ks + (row - 64) * 72) + ch * 8;
      *reinterpret_cast<u32x4*>(dst) = qk[k];
    }
#pragma unroll
    for (int k = 0; k < 6; ++k) {
      const u32x4 w = vv[k];
      u16* d = VT + (ch * 8) * 200 + rb + 32 * k;
      d[0] = (u16)(w.x & 0xffff); d[200] = (u16)(w.x >> 16); d[400] = (u16)(w.y & 0xffff); d[600] = (u16)(w.y >> 16);
      d[800] = (u16)(w.z & 0xffff); d[1000] = (u16)(w.z >> 16); d[1200] = (u16)(w.w & 0xffff); d[1400] = (u16)(w.w >> 16);
    }
  }
  __syncthreads();
  {
    const int e = tid & 7, rb = tid >> 3;
#pragma unroll
    for (int k = 0; k < 8; ++k) {
      const int row = rb + 32 * k;
      const int i = (k < 2) ? nb * 64 + row : nb * 64 - 128 + row;
      if (i >= 0 && i < L) {
        const size_t tok = tokbase + (size_t)i * dl + r;
        const float* rp = p.rope + (tok + (size_t)half * 8192) * 16;
        const float cs = rp[e], sn = rp[8 + e];
        u16* buf = (k < 2) ? Qs + row * 72 : Ks + (row - 64) * 72;
        const float x1 = bf2f(buf[e]), x2 = bf2f(buf[8 + e]);
        buf[e] = f2bf(x1 * cs - x2 * sn); buf[8 + e] = f2bf(x2 * cs + x1 * sn);
      }
    }
  }
  __syncthreads();
  f32x4 sc[12];
  {
    const bf16x8 q0 = ld8(Qs + (16 * wid + fr) * 72 + fq * 8), q1 = ld8(Qs + (16 * wid + fr) * 72 + 32 + fq * 8);
#pragma unroll
    for (int kt = 0; kt < 12; ++kt) {
      f32x4 a = (f32x4){0.f, 0.f, 0.f, 0.f};
      a = mfma16(ld8(Ks + (kt * 16 + fr) * 72 + fq * 8), q0, a);
      a = mfma16(ld8(Ks + (kt * 16 + fr) * 72 + 32 + fq * 8), q1, a);
      sc[kt] = a;
    }
  }
  const int qi = nb * 64 + 16 * wid + fr;
  float mx = -3.0e38f;
#pragma unroll
  for (int kt = 0; kt < 12; ++kt)
#pragma unroll
    for (int e = 0; e < 4; ++e) {
      const int j = nb * 64 - 64 + kt * 16 + fq * 4 + e;
      const int d = qi - j;
      const bool valid = (j >= 0) && (j < L) && (d <= 64) && (d >= -64);
      const float s = valid ? sc[kt][e] * 0.125f : -1e30f;
      sc[kt][e] = s; mx = fmaxf(mx, s);
    }
  mx = fmaxf(mx, __shfl_xor(mx, 16)); mx = fmaxf(mx, __shfl_xor(mx, 32));
  float den = 0.f;
#pragma unroll
  for (int kt = 0; kt < 12; ++kt)
#pragma unroll
    for (int e = 0; e < 4; ++e) { const float pe = __expf(sc[kt][e] - mx); sc[kt][e] = pe; den += pe; }
  den += __shfl_xor(den, 16); den += __shfl_xor(den, 32);
  __syncthreads();
#pragma unroll
  for (int kt = 0; kt < 12; ++kt) {
    u32x2 w; w.x = pk_bf16(sc[kt][0], sc[kt][1]); w.y = pk_bf16(sc[kt][2], sc[kt][3]);
    *reinterpret_cast<u32x2*>(Ps + (16 * wid + fr) * 200 + kt * 16 + fq * 4) = w;
  }
  __syncthreads();
  const float inv = 1.f / den;
  const size_t tokq = tokbase + (size_t)qi * dl + r;
#pragma unroll
  for (int dt = 0; dt < 4; ++dt) {
    f32x4 a = (f32x4){0.f, 0.f, 0.f, 0.f};
#pragma unroll
    for (int ks = 0; ks < 6; ++ks) a = mfma16(ld8(VT + (dt * 16 + fr) * 200 + ks * 32 + fq * 8), ld8(Ps + (16 * wid + fr) * 200 + ks * 32 + fq * 8), a);
    u32x2 w; w.x = pk_bf16(a[0] * inv, a[1] * inv); w.y = pk_bf16(a[2] * inv, a[3] * inv);
    *reinterpret_cast<u32x2*>(p.proj + tokq * LDP + cq + dt * 16 + fq * 4) = w;
  }
  if (fq == 0) p.lse[((size_t)pt * 8192 + tokq) * 4 + h] = mx + __logf(den);
}

__device__ void phase_scan_attn(const Params& p, int l, int half, unsigned char* smem) {
  const int bi = obid(), G = gridDim.x;
  const int nscan_blocks = G >= 256 ? 128 : G / 2;
  if (bi < nscan_blocks) {
    for (int t = bi; t < 128; t += nscan_blocks) {
      const int sid = (t & 7) * 16 + (t >> 3);
      scan_task(p, sid, smem);
    }
  } else {
    const int na = G - nscan_blocks;
    for (int t = bi - nscan_blocks; t < 1536; t += na) attn_task(p, t, half, smem);
    if (half == 0) {
      const float* xsrc = (l == 0) ? p.x : p.xres;
      u16* h1 = p.proj + (size_t)8192 * LDP;
      for (int t = bi - nscan_blocks; t < 8192 / 16; t += na) norm_task(xsrc + (size_t)8192 * DM, p.norm_mix + l * DM, h1, nullptr, t);
      for (int t = bi - nscan_blocks; t < (DM / 64) * (DM / 64); t += na) wconv_task(p.w_o + (size_t)l * DM * DM, DM, DM, DM, p.WB, t, smem);
    } else {
      for (int t = bi - nscan_blocks; t < (DM / 64) * (2 * DFF / 64); t += na)
        wconv_task(p.w_up + (size_t)l * DM * 2 * DFF, DM, 2 * DFF, 2 * DFF, p.WA, t, smem, true);
    }
  }
}

__device__ void combine_task(const Params& p, int l, int task) {
  const int lane = otid() & 63, wid = otid() >> 6;
  const int g16 = lane >> 4;
#pragma unroll 2
  for (int rr = 0; rr < 4; ++rr) {
    const size_t row = (size_t)task * 16 + wid * 4 + rr;
    const int t = (int)(row & (SEQ - 1));
    const u16* rp = p.proj + row * LDP;
    float ya[4];
    {
      const int c = 4 * lane;
      const float* cw = p.conv_a + (size_t)l * 3 * 256 + c;
      float z[4] = {0.f, 0.f, 0.f, 0.f};
#pragma unroll
      for (int i = 0; i < 3; ++i) {
        const int tt = t + i - 1;
        if (tt < 0 || tt >= SEQ) continue;
        const u16* r2 = rp + (ptrdiff_t)(i - 1) * LDP;
        const u32x2 xa = *reinterpret_cast<const u32x2*>(r2 + c), gc = *reinterpret_cast<const u32x2*>(r2 + 512 + c);
        const f32x4 w = *reinterpret_cast<const f32x4*>(cw + i * 256);
        z[0] += w[0] * bflo(xa.x) * bflo(gc.x); z[1] += w[1] * bfhi(xa.x) * bfhi(gc.x);
        z[2] += w[2] * bflo(xa.y) * bflo(gc.y); z[3] += w[3] * bfhi(xa.y) * bfhi(gc.y);
      }
      const u32x2 gb = *reinterpret_cast<const u32x2*>(rp + 256 + c);
      z[0] *= bflo(gb.x); z[1] *= bfhi(gb.x); z[2] *= bflo(gb.y); z[3] *= bfhi(gb.y);
      float ss = z[0] * z[0] + z[1] * z[1] + z[2] * z[2] + z[3] * z[3];
#pragma unroll
      for (int o = 1; o < 16; o <<= 1) ss += __shfl_xor(ss, o);
      const float rs = rsqrtf(ss * (1.f / 64.f) + EPS);
      const f32x4 g = *reinterpret_cast<const f32x4*>(p.norm_a + l * 256 + c);
#pragma unroll
      for (int e = 0; e < 4; ++e) ya[e] = z[e] * rs * g[e];
    }
    float yb[8];
    {
      const int c = 8 * lane, hh = g16, cc = c & 127;
      const int n = t >> 6, ci = t & 63;
      float of[8], ob[8], gt[8];
      unpack8(ldu4(rp + C_VDN + c), of);
      const u16* blk = p.inter + ((size_t)((row >> 11) * 4 + hh) * 32 + n) * 32768;
      unpack8(ldu4(blk + 8192 + (63 - ci) * 128 + cc), ob);
      unpack8(ldu4(rp + C_GATE + c), gt);
      float ss = 0.f;
#pragma unroll
      for (int e = 0; e < 8; ++e) { of[e] += ob[e]; ss += of[e] * of[e]; }
#pragma unroll
      for (int o = 1; o < 16; o <<= 1) ss += __shfl_xor(ss, o);
      const float rs = rsqrtf(ss * (1.f / 128.f) + EPS);
      const float* g = p.norm_dn + l * 128 + cc;
#pragma unroll
      for (int e = 0; e < 8; ++e) yb[e] = of[e] * rs * g[e] * silu_f(gt[e]);
    }
    float yc[4];
    {
      const int c = 4 * lane, hh = g16;
      const float l0 = p.lse[((size_t)0 * 8192 + row) * 4 + hh], l1 = p.lse[((size_t)1 * 8192 + row) * 4 + hh], l2 = p.lse[((size_t)2 * 8192 + row) * 4 + hh];
      const float mxl = fmaxf(l0, fmaxf(l1, l2));
      float a0 = __expf(l0 - mxl), a1 = __expf(l1 - mxl), a2 = __expf(l2 - mxl);
      const float is = 1.f / (a0 + a1 + a2); a0 *= is; a1 *= is; a2 *= is;
      const u32x2 o0 = *reinterpret_cast<const u32x2*>(rp + C_QC + c), o1 = *reinterpret_cast<const u32x2*>(rp + C_QC + 256 + c), o2 = *reinterpret_cast<const u32x2*>(rp + C_QC + 512 + c);
      float o[4];
      o[0] = a0 * bflo(o0.x) + a1 * bflo(o1.x) + a2 * bflo(o2.x); o[1] = a0 * bfhi(o0.x) + a1 * bfhi(o1.x) + a2 * bfhi(o2.x);
      o[2] = a0 * bflo(o0.y) + a1 * bflo(o1.y) + a2 * bflo(o2.y); o[3] = a0 * bfhi(o0.y) + a1 * bfhi(o1.y) + a2 * bfhi(o2.y);
      float ss = o[0] * o[0] + o[1] * o[1] + o[2] * o[2] + o[3] * o[3];
#pragma unroll
      for (int of = 1; of < 16; of <<= 1) ss += __shfl_xor(ss, of);
      const float rs = rsqrtf(ss * (1.f / 64.f) + EPS);
      const f32x4 g = *reinterpret_cast<const f32x4*>(p.norm_c + l * 256 + c);
#pragma unroll
      for (int e = 0; e < 4; ++e) yc[e] = o[e] * rs * g[e];
    }
    u16* yp = p.proj + row * LDP + C_QDN;
    u32x2 w; w.x = pk_bf16(ya[0], ya[1]); w.y = pk_bf16(ya[2], ya[3]);
    *reinterpret_cast<u32x2*>(yp + 4 * lane) = w;
    *reinterpret_cast<u32x4*>(yp + 256 + 8 * lane) = pack8(yb);
    w.x = pk_bf16(yc[0], yc[1]); w.y = pk_bf16(yc[2], yc[3]);
    *reinterpret_cast<u32x2*>(yp + 768 + 4 * lane) = w;
  }
}

__device__ void ffn_fix_item(const Params& p, int l, u16* act, int tm, int item) {
  const int cc = item % 352, side = item / 352;
  const int jg = cc * 8, pos = (jg >> 6) * 128 + (jg & 63);
  const int row = tm * 256 + (side ? 255 : 0), tseq = row & (SEQ - 1);
  const u16* ub = p.ubnd + (size_t)tm * 4 * (2 * DFF) + pos;
  const u16* r0; const u16* r1; const u16* r2; bool z0 = false, z2 = false;
  if (side == 0) { r1 = ub; r2 = ub + 2 * DFF; if (tseq == 0) { z0 = true; r0 = ub; } else r0 = ub - (2 * DFF); }
  else { r0 = ub + 2 * (2 * DFF); r1 = ub + 3 * (2 * DFF); if (tseq == SEQ - 1) { z2 = true; r2 = r1; } else r2 = ub + 4 * (2 * DFF); }
  const float* cw = p.conv_ffn + (size_t)l * 3 * 2 * DFF;
  float g[8], v[8];
#pragma unroll
  for (int e = 0; e < 8; ++e) { g[e] = 0.f; v[e] = 0.f; }
#pragma unroll
  for (int i = 0; i < 3; ++i) {
    const u16* rp = i == 0 ? r0 : (i == 1 ? r1 : r2);
    const float mz = ((i == 0 && z0) || (i == 2 && z2)) ? 0.f : 1.f;
    float a[8], bq[8];
    unpack8(ldu4(rp), a); unpack8(ldu4(rp + 64), bq);
    const float* wg = cw + i * 2 * DFF + jg; const float* wv = wg + DFF;
#pragma unroll
    for (int e = 0; e < 8; ++e) { g[e] += mz * (wg[e] * a[e]); v[e] += mz * (wv[e] * bq[e]); }
  }
  float o[8];
#pragma unroll
  for (int e = 0; e < 8; ++e) o[e] = silu_f(g[e]) * v[e];
  *reinterpret_cast<u32x4*>(act + (size_t)row * DFF + jg) = pack8(o);
}

constexpr int STEPS_PER_LAYER = 14;
constexpr int NSTEPS = 2 * STEPS_PER_LAYER + 1;

__device__ void run_step(const Params& p, int step, float* out, unsigned char* smem) {
  if (step == NSTEPS - 1) {
    for (int t = obid(); t < M_TOK / 16; t += gridDim.x) norm_task(p.xres, p.norm_final, nullptr, out, t);
    return;
  }
  const int l = step / STEPS_PER_LAYER, s = step % STEPS_PER_LAYER;
  u16* h = p.inter;
  if (s == 0) {
    phase_norm_w(p, l, 0, 0, true, smem);
  } else if (s < 11) {
    const int half = (s - 1) / 5, q = (s - 1) % 5;
    float* xh = p.xres + (size_t)half * 8192 * DM;
    const float* rin = (l == 0) ? (p.x + (size_t)half * 8192 * DM) : xh;
    const u16* hA = half ? (p.proj + (size_t)8192 * LDP) : h;
    switch (q) {
      case 0: gemm256_phase<EPI_PROJ>(hA, DM, p.WA, 8192, LDP, DM, p.proj, LDP, nullptr, nullptr, p.halo, smem); break;
      case 1: for (int t = obid(); t < 512; t += gridDim.x) dn_local_task(p, l, t, smem); break;
      case 2: phase_scan_attn(p, l, half, smem); break;
      case 3: for (int t = obid(); t < 8192 / 16; t += gridDim.x) combine_task(p, l, t); break;
      default: gemm_phase<EPI_RES>(p.proj + C_QDN, LDP, p.WB, 8192, DM, DM, nullptr, DM, xh, rin, nullptr, smem); break;
    }
  } else if (s == 11) {
    phase_norm_w(p, l, 1, 0, true, smem);
  } else {
    u16* act = p.proj;
    if (s == 12) gemm256_phase<EPI_UPACT>(h, DM, p.WA, M_TOK, 2 * DFF, DM, act, DFF, nullptr, p.conv_ffn + (size_t)l * 3 * 2 * DFF, p.ubnd, smem);
    else {
#pragma unroll 1
      for (int q = obid() >> 3; q < 8 * 8; q += (gridDim.x >> 3)) {
        const int tm = (obid() & 7) * 8 + (q & 7);
#pragma unroll 1
        for (int it = otid(); it < 704; it += NT) ffn_fix_item(p, l, act, tm, it);
      }
      asm volatile("s_waitcnt vmcnt(0)" ::: "memory");
      __syncthreads();
      gemm256_phase<EPI_RES>(act, DFF, p.WB, M_TOK, DM, DFF, nullptr, DM, p.xres, p.xres, nullptr, smem);
      if (l + 1 < 2) { for (int t = obid(); t < (DM / 64) * (LDP / 64); t += gridDim.x) wconv_task(p.w_in + (size_t)(l + 1) * DM * INW, DM, INW, LDP, p.WA, t, smem); }
    }
  }
}

#define XB_TMO      128
#define XB_XCNT(j)  (256  + 64 * (j))
#define XB_XSUB(j)  (1280 + 64 * (j))
#define XB_XGEN(j)  (2304 + 64 * (j))
#define XB_TOP      3328
#define XB_TOPGEN   3392
#define XCD_BAR_WORDS 3456
#define XB_SPIN_CAP (1u << 18)
#define LAS __attribute__((address_space(3)))

__device__ __forceinline__ unsigned xb_ld(unsigned* p)              { return __hip_atomic_load(p, __ATOMIC_RELAXED, __HIP_MEMORY_SCOPE_AGENT); }
__device__ __forceinline__ unsigned xb_add(unsigned* p, unsigned v) { return __hip_atomic_fetch_add(p, v, __ATOMIC_RELAXED, __HIP_MEMORY_SCOPE_AGENT); }
__device__ __forceinline__ unsigned xb_xcc_id() { return (unsigned)__builtin_amdgcn_s_getreg((3 << 11) | 20) & 0xFu; }
#define XB_SPIN(cond, bar) do { unsigned _sp = 0; while (cond) { __builtin_amdgcn_s_sleep(1); \
    if ((++_sp & 255u) == 0u) { if (xb_ld(&(bar)[XB_TMO])) break; if (_sp > XB_SPIN_CAP) { atomicAdd(&(bar)[XB_TMO], 1u); break; } } } } while (0)

struct XcdBarrier {
    unsigned* bar; unsigned x;
    volatile LAS unsigned* st;
};

__device__ __forceinline__ XcdBarrier xcd_barrier_post(unsigned* bar, volatile LAS unsigned* st) {
    XcdBarrier b; b.bar = bar; b.x = xb_xcc_id(); b.st = st;
    if (threadIdx.x == 0) (void)xb_add(&bar[XB_XCNT(b.x)], 1u);
    return b;
}
__device__ __forceinline__ void xcd_barrier_complete(unsigned* bar, unsigned x, unsigned& nloc, unsigned& nx) {
    const unsigned G = gridDim.x * gridDim.y * gridDim.z;
    unsigned sum, cnt, mine, sp = 0u;
    for (;;) {
        sum = 0u; cnt = 0u; mine = 0u;
#pragma unroll
        for (unsigned j = 0; j < 16; ++j) { const unsigned c = xb_ld(&bar[XB_XCNT(j)]); sum += c; cnt += (c > 0u) ? 1u : 0u; mine = (j == x) ? c : mine; }
        if (sum == G) break;
        __builtin_amdgcn_s_sleep(1);
        if ((++sp & 255u) == 0u) { if (xb_ld(&bar[XB_TMO])) break; if (sp > XB_SPIN_CAP) { atomicAdd(&bar[XB_TMO], 1u); break; } }
    }
    nloc = mine > 0u ? mine : 1u; nx = cnt > 0u ? cnt : 1u;
}

__device__ __forceinline__ void xcd_barrier(const XcdBarrier& b) {
    asm volatile("s_waitcnt vmcnt(0)" ::: "memory");
    __syncthreads();
    if (threadIdx.x == 0) {
        unsigned* bar = b.bar;
        __builtin_amdgcn_s_waitcnt(0);
        unsigned nloc = b.st[0], nx = b.st[1];
        if (nloc == 0u) { xcd_barrier_complete(bar, b.x, nloc, nx); b.st[0] = nloc; b.st[1] = nx; }
        const unsigned old = xb_add(&bar[XB_XSUB(b.x)], 1u);
        const unsigned gen = old / nloc;
        if (old + 1u == (gen + 1u) * nloc) {
            __builtin_amdgcn_fence(__ATOMIC_RELEASE, "agent");
            asm volatile("s_waitcnt vmcnt(0)" ::: "memory");
            const unsigned og = xb_add(&bar[XB_TOP], 1u);
            const unsigned tg = og / nx;
            if (og + 1u == (tg + 1u) * nx) xb_add(&bar[XB_TOPGEN], 1u);
            else XB_SPIN(xb_ld(&bar[XB_TOPGEN]) == tg, bar);
            __builtin_amdgcn_fence(__ATOMIC_ACQUIRE, "agent");
            xb_add(&bar[XB_XGEN(b.x)], 1u);
            asm volatile("s_waitcnt vmcnt(0)" ::: "memory");
        } else {
            XB_SPIN(xb_ld(&bar[XB_XGEN(b.x)]) == gen, bar);
            __builtin_amdgcn_fence(__ATOMIC_ACQUIRE, "agent");
            asm volatile("s_waitcnt vmcnt(0)" ::: "memory");
        }
    }
    __syncthreads();
}


__device__ __forceinline__ void grid_bar(unsigned* ctr, unsigned target) {
  asm volatile("s_waitcnt vmcnt(0)" ::: "memory");
  __syncthreads();
  if (otid() == 0) {
    __builtin_amdgcn_fence(__ATOMIC_RELEASE, "agent");
    asm volatile("s_waitcnt vmcnt(0)" ::: "memory");
    const unsigned grp = obid() & 7u, gsz = gridDim.x >> 3;
    unsigned* cg_ = ctr + 64 * (1 + grp);
    const unsigned old = __hip_atomic_fetch_add(cg_, 1u, __ATOMIC_RELAXED, __HIP_MEMORY_SCOPE_AGENT);
    if (old + 1 == target * gsz) __hip_atomic_fetch_add(ctr, 1u, __ATOMIC_RELAXED, __HIP_MEMORY_SCOPE_AGENT);
    while (__hip_atomic_load(ctr, __ATOMIC_RELAXED, __HIP_MEMORY_SCOPE_AGENT) < target * 8u) { }
    __builtin_amdgcn_fence(__ATOMIC_ACQUIRE, "agent");
  }
  __syncthreads();
}

__global__ void __launch_bounds__(NT, 2) mega_kernel(Params p, int step_lo, int step_hi) {
  extern __shared__ __attribute__((aligned(16))) unsigned char smem[];
  cg::grid_group grid = cg::this_grid();
  __shared__ unsigned xb_words[4];
  if (threadIdx.x == 0) { xb_words[0] = 0u; xb_words[1] = 0u; }
  __syncthreads();
  const XcdBarrier xb = xcd_barrier_post(p.bar, (volatile LAS unsigned*)&xb_words);
  for (int step = step_lo; step < step_hi; ++step) {
    run_step(p, step, (float*)p.out, smem);
    if (step + 1 < step_hi) {
      if (step_hi < 0) grid.sync();
      xcd_barrier(xb);
    }
  }
}

extern "C" void kernel_launch(void* const* d_in, const int* in_sizes, int n_in, void* d_out, int out_size, void* d_ws, size_t ws_size,
                              hipStream_t stream) {
  static int grid_blocks = 0;
  if (!grid_blocks) {
    int dev = 0, cus = 0, per_cu = 0;
    hipGetDevice(&dev);
    hipDeviceGetAttribute(&cus, hipDeviceAttributeMultiprocessorCount, dev);
    hipFuncSetAttribute((const void*)mega_kernel, hipFuncAttributeMaxDynamicSharedMemorySize, SMEM_BYTES);
    hipOccupancyMaxActiveBlocksPerMultiprocessor(&per_cu, mega_kernel, NT, SMEM_BYTES);
    if (per_cu > 2) per_cu = 2;
    if (per_cu < 1) per_cu = 1;
    grid_blocks = cus * per_cu;
    grid_blocks -= grid_blocks % 8;
  }
  Params p{};
  p.x = (const float*)d_in[0]; p.pos = (const int*)d_in[1]; p.norm_mix = (const float*)d_in[2]; p.w_in = (const float*)d_in[3];
  p.conv_a = (const float*)d_in[4]; p.norm_a = (const float*)d_in[5]; p.conv_qkv = (const float*)d_in[6];
  p.a_log_f = (const float*)d_in[7]; p.a_log_b = (const float*)d_in[8]; p.dt_bias_f = (const float*)d_in[9]; p.dt_bias_b = (const float*)d_in[10];
  p.norm_dn = (const float*)d_in[11]; p.norm_c = (const float*)d_in[12]; p.w_o = (const float*)d_in[13]; p.norm_ffn = (const float*)d_in[14];
  p.w_up = (const float*)d_in[15]; p.conv_ffn = (const float*)d_in[16]; p.w_down = (const float*)d_in[17]; p.norm_final = (const float*)d_in[18];
  p.out = (float*)d_out;
  unsigned char* ws = (unsigned char*)d_ws;
  size_t off = 0;
  p.proj = (u16*)(ws + off); off += (size_t)8192 * 3 * DFF * 2;
  p.inter = (u16*)(ws + off); off += (size_t)512 * 65536;
  p.WA = (u16*)(ws + off); off += (size_t)2 * DFF * DM * 2;
  p.WB = (u16*)(ws + off); off += (size_t)DM * DFF * 2;
  p.halo = (u16*)(ws + off); off += (size_t)256 * 1536 * 2;
  p.lse = (float*)(ws + off); off += (size_t)3 * 8192 * 4 * 4;
  p.gexp = (float*)(ws + off); off += (size_t)1024 * 192 * 4;
  p.rope = (float*)(ws + off); off += (size_t)M_TOK * 16 * 4;
  p.xres = (float*)(ws + off); off += (size_t)M_TOK * DM * 4;
  p.bar = (unsigned*)(ws + off); off += 16384;
  p.ubnd = (u16*)(ws + off); off += (size_t)128 * 4 * 2 * DFF * 2;
  if (off > ws_size) { fprintf(stderr, "workspace too small: need %zu have %zu\n", off, ws_size); return; }
#if MEGA
  hipMemsetAsync(p.bar, 0, 16384, stream);
  int lo = 0, hi = NSTEPS;
  void* args[] = {&p, &lo, &hi};
  hipError_t e = hipLaunchCooperativeKernel((const void*)mega_kernel, dim3(grid_blocks), dim3(NT), args, SMEM_BYTES, stream);
  if (e != hipSuccess) fprintf(stderr, "cooperative launch failed: %s (grid %d)\n", hipGetErrorString(e), grid_blocks);
#else
  for (int s = 0; s < NSTEPS; ++s) hipLaunchKernelGGL(mega_kernel, dim3(grid_blocks), dim3(NT), SMEM_BYTES, stream, p, s, s + 1);
#endif
}
```

```cpp
#include <hip/hip_runtime.h>
#include <hip/hip_cooperative_groups.h>
#include <cstdio>
#include <cstdint>
namespace cg = cooperative_groups;

#ifndef MEGA
#define MEGA 1
#endif

typedef unsigned short u16;
typedef short bf16x8 __attribute__((ext_vector_type(8)));
typedef float f32x4 __attribute__((ext_vector_type(4)));
typedef unsigned u32x4 __attribute__((ext_vector_type(4)));
typedef unsigned u32x2 __attribute__((ext_vector_type(2)));

constexpr int NT = 256;
constexpr int M_TOK = 16384, SEQ = 2048, DM = 1024;
constexpr int LDP = 5248;
constexpr int INW = 5136;
constexpr int DFF = 2816;
constexpr int C_QDN = 768, C_KDN = 1280, C_VDN = 1792, C_GATE = 2304, C_BF = 2816, C_BB = 2820, C_AF = 2824, C_AB = 2828;
constexpr int C_QC = 2832, C_KC = 3600, C_VC = 4368;
constexpr float EPS = 1e-6f;
constexpr int SMEM_BYTES = 73728;

struct Params {
  const float* x; const int* pos; const float* norm_mix; const float* w_in; const float* conv_a; const float* norm_a;
  const float* conv_qkv; const float* a_log_f; const float* a_log_b; const float* dt_bias_f; const float* dt_bias_b;
  const float* norm_dn; const float* norm_c; const float* w_o; const float* norm_ffn; const float* w_up; const float* conv_ffn;
  const float* w_down; const float* norm_final;
  float* xres;
  float* out;
  u16* proj;
  u16* inter;
  u16* WA; u16* WB; u16* halo; float* lse; float* gexp; float* rope;
  u16* ubnd;
  unsigned* bar;
};

__device__ __forceinline__ int obid() { int b = __builtin_amdgcn_workgroup_id_x(); asm volatile("" : "+s"(b)); return b; }
__device__ __forceinline__ int otid() { int t = __builtin_amdgcn_workitem_id_x(); asm volatile("" : "+v"(t)); return t; }
typedef float f32x2_t __attribute__((ext_vector_type(2)));
typedef __bf16 bf16x2_t __attribute__((ext_vector_type(2)));
__device__ __forceinline__ unsigned pk_bf16(float lo, float hi) {
  f32x2_t v = {lo, hi};
  bf16x2_t b = __builtin_convertvector(v, bf16x2_t);
  return __builtin_bit_cast(unsigned, b);
}
__device__ __forceinline__ u16 f2bf(float f) { return (u16)(pk_bf16(f, 0.f) & 0xffffu); }
__device__ __forceinline__ float bf2f(u16 h) { return __uint_as_float(((unsigned)h) << 16); }
__device__ __forceinline__ float bflo(unsigned w) { return __uint_as_float(w << 16); }
__device__ __forceinline__ float bfhi(unsigned w) { return __uint_as_float(w & 0xffff0000u); }
__device__ __forceinline__ float silu_f(float x) { return x / (1.f + __expf(-x)); }
__device__ __forceinline__ f32x4 mfma16(bf16x8 a, bf16x8 b, f32x4 c) { return __builtin_amdgcn_mfma_f32_16x16x32_bf16(a, b, c, 0, 0, 0); }
__device__ __forceinline__ bf16x8 ld8(const u16* p) { return *reinterpret_cast<const bf16x8*>(p); }
__device__ __forceinline__ u32x4 ldu4(const u16* p) { return *reinterpret_cast<const u32x4*>(p); }
__device__ __forceinline__ void unpack8(u32x4 w, float* f) {
  f[0] = bflo(w.x); f[1] = bfhi(w.x); f[2] = bflo(w.y); f[3] = bfhi(w.y);
  f[4] = bflo(w.z); f[5] = bfhi(w.z); f[6] = bflo(w.w); f[7] = bfhi(w.w);
}
__device__ __forceinline__ u32x4 pack8(const float* f) {
  u32x4 w; w.x = pk_bf16(f[0], f[1]); w.y = pk_bf16(f[2], f[3]); w.z = pk_bf16(f[4], f[5]); w.w = pk_bf16(f[6], f[7]); return w;
}

constexpr int EPI_PROJ = 0, EPI_RES = 1, EPI_BF16 = 2, EPI_UPACT = 3;
constexpr int GLD = 64;
constexpr int GBUF = 2 * 128 * GLD;

template <int EPI>
__device__ void gemm_phase(const u16* __restrict__ A, int lda, const u16* __restrict__ Bt, int Mrows, int N, int K,
                           u16* Cb, int ldc, float* Cres, const float* Rin, u16* halo, unsigned char* smem) {
  u16* As = (u16*)smem;
  u16* Bs = As + 128 * GLD;
  const int tid = otid(), lane = tid & 63, wid = tid >> 6, wr = wid >> 1, wc = wid & 1;
  const int fr = lane & 15, fq = lane >> 4;
  const int ntm = Mrows / 128, ntn = N / 128, ntiles = ntm * ntn;
  const int nk = K / 64;
  const int xcd = obid() & 7, jb = obid() >> 3, nper = gridDim.x >> 3, tmper = ntm >> 3;
  (void)ntiles;
  for (int q = jb; q < tmper * ntn; q += nper) {
    const int tm = xcd * tmper + (q % tmper), tn = q / tmper;
    const int m0 = tm * 128, n0 = tn * 128;
    f32x4 acc[4][4];
#pragma unroll
    for (int i = 0; i < 4; ++i)
#pragma unroll
      for (int j = 0; j < 4; ++j) acc[i][j] = (f32x4){0.f, 0.f, 0.f, 0.f};
    u32x4 ra0[4], rb0[4], ra1[4], rb1[4];
    const int lrow = tid >> 3, lch = tid & 7;
    const int swc = lch ^ (lrow & 7);
    const u16* Ag = A + (size_t)(m0 + lrow) * lda + lch * 8;
    const u16* Bg = Bt + (size_t)(n0 + lrow) * K + lch * 8;
#define G_LOAD(RA, RB, KT) do { const int ko_ = (KT) * 64; _Pragma("unroll") for (int i = 0; i < 4; ++i) { RA[i] = ldu4(Ag + (size_t)(i * 32) * lda + ko_); RB[i] = ldu4(Bg + (size_t)(i * 32) * K + ko_); } } while (0)
#define G_STORE(RA, RB, ST) do { u16* An_ = As + (ST) * GBUF; u16* Bn_ = Bs + (ST) * GBUF; _Pragma("unroll") for (int i = 0; i < 4; ++i) { \
      *reinterpret_cast<u32x4*>(An_ + (lrow + i * 32) * GLD + swc * 8) = RA[i]; *reinterpret_cast<u32x4*>(Bn_ + (lrow + i * 32) * GLD + swc * 8) = RB[i]; } } while (0)
#define G_COMPUTE(ST) do { const u16* Ac = As + (ST) * GBUF; const u16* Bc = Bs + (ST) * GBUF; _Pragma("unroll") for (int ks = 0; ks < 2; ++ks) { \
      bf16x8 af[4], bfr[4]; _Pragma("unroll") for (int i = 0; i < 4; ++i) { \
        af[i] = ld8(Ac + (wr * 64 + i * 16 + fr) * GLD + (((ks * 4 + fq) ^ (fr & 7)) * 8)); \
        bfr[i] = ld8(Bc + (wc * 64 + i * 16 + fr) * GLD + (((ks * 4 + fq) ^ (fr & 7)) * 8)); } \
      __builtin_amdgcn_s_setprio(1); \
      _Pragma("unroll") for (int mt = 0; mt < 4; ++mt) _Pragma("unroll") for (int nt = 0; nt < 4; ++nt) acc[mt][nt] = mfma16(bfr[nt], af[mt], acc[mt][nt]); \
      __builtin_amdgcn_s_setprio(0); } } while (0)
    G_LOAD(ra0, rb0, 0);
    G_LOAD(ra1, rb1, 1);
    __syncthreads();
    G_STORE(ra0, rb0, 0);
    __syncthreads();
    for (int kt = 0; kt < nk; kt += 2) {
      if (kt + 2 < nk) G_LOAD(ra0, rb0, kt + 2);
      G_COMPUTE(0);
      G_STORE(ra1, rb1, 1);
      __syncthreads();
      if (kt + 3 < nk) G_LOAD(ra1, rb1, kt + 3);
      G_COMPUTE(1);
      if (kt + 2 < nk) G_STORE(ra0, rb0, 0);
      __syncthreads();
    }
#undef G_LOAD
#undef G_STORE
#undef G_COMPUTE
    if (EPI == EPI_UPACT) {
      u16* T = (u16*)smem;
#pragma unroll
      for (int mt = 0; mt < 4; ++mt)
#pragma unroll
        for (int nt = 0; nt < 4; ++nt) {
          const f32x4 v = acc[mt][nt];
          u32x2 w; w.x = pk_bf16(v[0], v[1]); w.y = pk_bf16(v[2], v[3]);
          *reinterpret_cast<u32x2*>(T + (wr * 64 + mt * 16 + fr) * 136 + wc * 64 + nt * 16 + fq * 4) = w;
        }
      __syncthreads();
      const int jc = tid & 7, jg = tn * 64 + jc * 8;
      const float* cw = Rin;
      float wg[3][8], wv[3][8];
#pragma unroll
      for (int i = 0; i < 3; ++i)
#pragma unroll
        for (int e4 = 0; e4 < 2; ++e4) {
          const f32x4 a = *reinterpret_cast<const f32x4*>(cw + i * 2 * DFF + jg + e4 * 4), bq = *reinterpret_cast<const f32x4*>(cw + i * 2 * DFF + DFF + jg + e4 * 4);
#pragma unroll
          for (int e = 0; e < 4; ++e) { wg[i][e4 * 4 + e] = a[e]; wv[i][e4 * 4 + e] = bq[e]; }
        }
#pragma unroll 1
      for (int k = 0; k < 4; ++k) {
        const int t = (tid >> 3) + 32 * k;
        if (t >= 1 && t <= 126) {
          float g[8], vv[8];
#pragma unroll
          for (int e = 0; e < 8; ++e) { g[e] = 0.f; vv[e] = 0.f; }
#pragma unroll
          for (int i = 0; i < 3; ++i) {
            float a[8], bq[8];
            unpack8(*reinterpret_cast<const u32x4*>(T + (t + i - 1) * 136 + jc * 8), a);
            unpack8(*reinterpret_cast<const u32x4*>(T + (t + i - 1) * 136 + 64 + jc * 8), bq);
#pragma unroll
            for (int e = 0; e < 8; ++e) { g[e] += wg[i][e] * a[e]; vv[e] += wv[i][e] * bq[e]; }
          }
          float o[8];
#pragma unroll
          for (int e = 0; e < 8; ++e) o[e] = silu_f(g[e]) * vv[e];
          *reinterpret_cast<u32x4*>(Cb + (size_t)(m0 + t) * ldc + jg) = pack8(o);
        }
        if (t <= 1 || t >= 126) {
          const int slot = (t <= 1) ? t : t - 124;
          u16* ub = halo + (size_t)(tm * 4 + slot) * (2 * DFF) + n0;
          *reinterpret_cast<u32x4*>(ub + jc * 8) = *reinterpret_cast<const u32x4*>(T + t * 136 + jc * 8);
          *reinterpret_cast<u32x4*>(ub + 64 + jc * 8) = *reinterpret_cast<const u32x4*>(T + t * 136 + 64 + jc * 8);
        }
      }
      continue;
    }
    if (EPI == EPI_RES) {
      f32x4 r[4][4];
#pragma unroll
      for (int mt = 0; mt < 4; ++mt)
#pragma unroll
        for (int nt = 0; nt < 4; ++nt) r[mt][nt] = *reinterpret_cast<const f32x4*>(Rin + (size_t)(m0 + wr * 64 + mt * 16 + fr) * ldc + n0 + wc * 64 + nt * 16 + fq * 4);
#pragma unroll
      for (int mt = 0; mt < 4; ++mt)
#pragma unroll
        for (int nt = 0; nt < 4; ++nt) *reinterpret_cast<f32x4*>(Cres + (size_t)(m0 + wr * 64 + mt * 16 + fr) * ldc + n0 + wc * 64 + nt * 16 + fq * 4) = r[mt][nt] + acc[mt][nt];
      continue;
    }
#pragma unroll
    for (int mt = 0; mt < 4; ++mt) {
      const int m = m0 + wr * 64 + mt * 16 + fr;
#pragma unroll
      for (int nt = 0; nt < 4; ++nt) {
        const int n = n0 + wc * 64 + nt * 16 + fq * 4;
        const f32x4 v = acc[mt][nt];
        if (EPI == EPI_RES) {
          float* p = Cres + (size_t)m * ldc + n;
          f32x4 o = *reinterpret_cast<const f32x4*>(Rin + (size_t)m * ldc + n);
          o += v;
          *reinterpret_cast<f32x4*>(p) = o;
        } else {
          u32x2 w; w.x = pk_bf16(v[0], v[1]); w.y = pk_bf16(v[2], v[3]);
          *reinterpret_cast<u32x2*>(Cb + (size_t)m * ldc + n) = w;
          if (EPI == EPI_PROJ) {
            const int mm = m & 63;
            if ((mm == 0 || mm == 63) && n >= C_QDN && n < C_GATE)
              *reinterpret_cast<u32x2*>(halo + (size_t)((m >> 6) * 2 + (mm == 63 ? 1 : 0)) * 1536 + (n - C_QDN)) = w;
          }
        }
      }
    }
  }
}

template <int EPI>
__device__ void gemm256_phase(const u16* __restrict__ A, int lda, const u16* __restrict__ Bt, int Mrows, int N, int K,
                              u16* Cb, int ldc, float* Cres, const float* Rin, u16* halo, unsigned char* smem) {
  u16* As = (u16*)smem;
  u16* Bs = As + 256 * 64;
  const int tid = otid(), lane = tid & 63, wid = tid >> 6, wr = wid >> 1, wc = wid & 1;
  const int fr = lane & 15, fq = lane >> 4;
  const int ntm = Mrows / 256, ntn = N / 128, nk = K / 64;
  const int xcd = obid() & 7, jb = obid() >> 3, nper = gridDim.x >> 3, tmper = ntm >> 3;
  for (int q = jb; q < tmper * ntn; q += nper) {
    const int tm = xcd * tmper + (q % tmper), tn = q / tmper;
    const int m0 = tm * 256, n0 = tn * 128;
    f32x4 acc[8][4];
#pragma unroll
    for (int i = 0; i < 8; ++i)
#pragma unroll
      for (int j = 0; j < 4; ++j) acc[i][j] = (f32x4){0.f, 0.f, 0.f, 0.f};
    u32x4 ra[8], rb[4];
    const int lrow = tid >> 3, lch = tid & 7;
    const int swc = lch ^ (lrow & 7);
    const u16* Ag = A + (size_t)(m0 + lrow) * lda + lch * 8;
    const u16* Bg = Bt + (size_t)(n0 + lrow) * K + lch * 8;
#pragma unroll
    for (int i = 0; i < 8; ++i) ra[i] = ldu4(Ag + (size_t)(i * 32) * lda);
#pragma unroll
    for (int i = 0; i < 4; ++i) rb[i] = ldu4(Bg + (size_t)(i * 32) * K);
    for (int kt = 0; kt < nk; ++kt) {
      __syncthreads();
#pragma unroll
      for (int i = 0; i < 8; ++i) *reinterpret_cast<u32x4*>(As + (lrow + i * 32) * 64 + swc * 8) = ra[i];
#pragma unroll
      for (int i = 0; i < 4; ++i) *reinterpret_cast<u32x4*>(Bs + (lrow + i * 32) * 64 + swc * 8) = rb[i];
      __syncthreads();
      if (kt + 1 < nk) {
        const int ko = (kt + 1) * 64;
#pragma unroll
        for (int i = 0; i < 8; ++i) ra[i] = ldu4(Ag + (size_t)(i * 32) * lda + ko);
#pragma unroll
        for (int i = 0; i < 4; ++i) rb[i] = ldu4(Bg + (size_t)(i * 32) * K + ko);
      }
#pragma unroll
      for (int ks = 0; ks < 2; ++ks) {
        const int sw = ((ks * 4 + fq) ^ (fr & 7)) * 8;
        bf16x8 bfr[4];
#pragma unroll
        for (int i = 0; i < 4; ++i) bfr[i] = ld8(Bs + (wc * 64 + i * 16 + fr) * 64 + sw);
#pragma unroll
        for (int mh = 0; mh < 2; ++mh) {
          bf16x8 af[4];
#pragma unroll
          for (int i = 0; i < 4; ++i) af[i] = ld8(As + (wr * 128 + (mh * 4 + i) * 16 + fr) * 64 + sw);
          __builtin_amdgcn_s_setprio(1);
#pragma unroll
          for (int i = 0; i < 4; ++i)
#pragma unroll
            for (int nt = 0; nt < 4; ++nt) acc[mh * 4 + i][nt] = mfma16(bfr[nt], af[i], acc[mh * 4 + i][nt]);
          __builtin_amdgcn_s_setprio(0);
        }
      }
    }
    if (EPI == EPI_UPACT) {
      u16* T = (u16*)smem;
      __syncthreads();
#pragma unroll
      for (int mt = 0; mt < 8; ++mt)
#pragma unroll
        for (int nt = 0; nt < 4; ++nt) {
          const f32x4 v = acc[mt][nt];
          u32x2 w; w.x = pk_bf16(v[0], v[1]); w.y = pk_bf16(v[2], v[3]);
          *reinterpret_cast<u32x2*>(T + (wr * 128 + mt * 16 + fr) * 136 + wc * 64 + nt * 16 + fq * 4) = w;
        }
      __syncthreads();
      const int jc = tid & 7, jg = tn * 64 + jc * 8;
      const float* cw = Rin;
      float wg[3][8], wv[3][8];
#pragma unroll
      for (int i = 0; i < 3; ++i)
#pragma unroll
        for (int e4 = 0; e4 < 2; ++e4) {
          const f32x4 a = *reinterpret_cast<const f32x4*>(cw + i * 2 * DFF + jg + e4 * 4), bq = *reinterpret_cast<const f32x4*>(cw + i * 2 * DFF + DFF + jg + e4 * 4);
#pragma unroll
          for (int e = 0; e < 4; ++e) { wg[i][e4 * 4 + e] = a[e]; wv[i][e4 * 4 + e] = bq[e]; }
        }
#pragma unroll 1
      for (int k = 0; k < 8; ++k) {
        const int t = (tid >> 3) + 32 * k;
        if (t >= 1 && t <= 254) {
          float g[8], vv[8];
#pragma unroll
          for (int e = 0; e < 8; ++e) { g[e] = 0.f; vv[e] = 0.f; }
#pragma unroll
          for (int i = 0; i < 3; ++i) {
            float a[8], bq[8];
            unpack8(*reinterpret_cast<const u32x4*>(T + (t + i - 1) * 136 + jc * 8), a);
            unpack8(*reinterpret_cast<const u32x4*>(T + (t + i - 1) * 136 + 64 + jc * 8), bq);
#pragma unroll
            for (int e = 0; e < 8; ++e) { g[e] += wg[i][e] * a[e]; vv[e] += wv[i][e] * bq[e]; }
          }
          float o[8];
#pragma unroll
          for (int e = 0; e < 8; ++e) o[e] = silu_f(g[e]) * vv[e];
          *reinterpret_cast<u32x4*>(Cb + (size_t)(m0 + t) * ldc + jg) = pack8(o);
        }
        if (t <= 1 || t >= 254) {
          const int slot = (t <= 1) ? t : t - 252;
          u16* ub = halo + (size_t)(tm * 4 + slot) * (2 * DFF) + n0;
          *reinterpret_cast<u32x4*>(ub + jc * 8) = *reinterpret_cast<const u32x4*>(T + t * 136 + jc * 8);
          *reinterpret_cast<u32x4*>(ub + 64 + jc * 8) = *reinterpret_cast<const u32x4*>(T + t * 136 + 64 + jc * 8);
        }
      }
      continue;
    }
    if (EPI == EPI_RES) {
#pragma unroll
      for (int mh = 0; mh < 2; ++mh) {
        f32x4 r[4][4];
#pragma unroll
        for (int mt = 0; mt < 4; ++mt)
#pragma unroll
          for (int nt = 0; nt < 4; ++nt) r[mt][nt] = *reinterpret_cast<const f32x4*>(Rin + (size_t)(m0 + wr * 128 + (mh * 4 + mt) * 16 + fr) * ldc + n0 + wc * 64 + nt * 16 + fq * 4);
#pragma unroll
        for (int mt = 0; mt < 4; ++mt)
#pragma unroll
          for (int nt = 0; nt < 4; ++nt) *reinterpret_cast<f32x4*>(Cres + (size_t)(m0 + wr * 128 + (mh * 4 + mt) * 16 + fr) * ldc + n0 + wc * 64 + nt * 16 + fq * 4) = r[mt][nt] + acc[mh * 4 + mt][nt];
      }
      continue;
    }
#pragma unroll
    for (int mt = 0; mt < 8; ++mt) {
      const int m = m0 + wr * 128 + mt * 16 + fr;
#pragma unroll
      for (int nt = 0; nt < 4; ++nt) {
        const int n = n0 + wc * 64 + nt * 16 + fq * 4;
        const f32x4 v = acc[mt][nt];
        if (EPI == EPI_RES) {
          float* p = Cres + (size_t)m * ldc + n;
          f32x4 o = *reinterpret_cast<const f32x4*>(Rin + (size_t)m * ldc + n);
          o += v;
          *reinterpret_cast<f32x4*>(p) = o;
        } else {
          u32x2 w; w.x = pk_bf16(v[0], v[1]); w.y = pk_bf16(v[2], v[3]);
          *reinterpret_cast<u32x2*>(Cb + (size_t)m * ldc + n) = w;
          if (EPI == EPI_PROJ) {
            const int mm = m & 63;
            if ((mm == 0 || mm == 63) && n >= C_QDN && n < C_GATE)
              *reinterpret_cast<u32x2*>(halo + (size_t)((m >> 6) * 2 + (mm == 63 ? 1 : 0)) * 1536 + (n - C_QDN)) = w;
          }
        }
      }
    }
  }
}

__device__ void norm_task(const float* src, const float* __restrict__ g, u16* dst, float* dstf, int task) {
  const int lane = otid() & 63, wid = otid() >> 6;
#pragma unroll 1
  for (int rr = 0; rr < 4; ++rr) {
    const int row = task * 16 + wid * 4 + rr;
    const float* s = src + (size_t)row * DM;
    f32x4 v[4]; float ss = 0.f;
#pragma unroll
    for (int i = 0; i < 4; ++i) { v[i] = *reinterpret_cast<const f32x4*>(s + i * 256 + lane * 4); ss += v[i][0] * v[i][0] + v[i][1] * v[i][1] + v[i][2] * v[i][2] + v[i][3] * v[i][3]; }
#pragma unroll
    for (int o = 1; o < 64; o <<= 1) ss += __shfl_xor(ss, o);
    const float rs = rsqrtf(ss * (1.f / DM) + EPS);
#pragma unroll
    for (int i = 0; i < 4; ++i) {
      const f32x4 gg = *reinterpret_cast<const f32x4*>(g + i * 256 + lane * 4);
      f32x4 y; y[0] = v[i][0] * rs * gg[0]; y[1] = v[i][1] * rs * gg[1]; y[2] = v[i][2] * rs * gg[2]; y[3] = v[i][3] * rs * gg[3];
      if (dstf) *reinterpret_cast<f32x4*>(dstf + (size_t)row * DM + i * 256 + lane * 4) = y;
      else { u32x2 w; w.x = pk_bf16(y[0], y[1]); w.y = pk_bf16(y[2], y[3]); *reinterpret_cast<u32x2*>(dst + (size_t)row * DM + i * 256 + lane * 4) = w; }
    }
  }
}

__device__ void wconv_task(const float* __restrict__ W, int K, int N, int Npad, u16* Wt, int task, unsigned char* smem, bool perm = false) {
  float* tl = (float*)smem;
  const int ntn = Npad / 64;
  const int tk = task / ntn, tn = task % ntn;
  const int k0 = tk * 64, n0 = tn * 64, tid = otid();
  __syncthreads();
#pragma unroll
  for (int i = 0; i < 4; ++i) {
    const int k = (tid >> 4) + 16 * i, n4 = (tid & 15) * 4;
    f32x4 v = (f32x4){0.f, 0.f, 0.f, 0.f};
    if (n0 + n4 < N) v = *reinterpret_cast<const f32x4*>(W + (size_t)(k0 + k) * N + n0 + n4);
    tl[k * 65 + n4 + 0] = v[0]; tl[k * 65 + n4 + 1] = v[1]; tl[k * 65 + n4 + 2] = v[2]; tl[k * 65 + n4 + 3] = v[3];
  }
  __syncthreads();
  const int n = tid >> 2, ks = (tid & 3) * 16;
  float f[16];
#pragma unroll
  for (int i = 0; i < 16; ++i) f[i] = tl[(ks + i) * 65 + n];
  const int dn0 = perm ? (n0 < DFF ? (n0 >> 6) * 128 : ((n0 - DFF) >> 6) * 128 + 64) : n0;
  u16* o = Wt + (size_t)(dn0 + n) * K + k0 + ks;
  *reinterpret_cast<u32x4*>(o) = pack8(f);
  *reinterpret_cast<u32x4*>(o + 8) = pack8(f + 8);
}

__device__ void phase_norm_w(const Params& p, int l, int mode, int half, bool with_w, unsigned char* smem) {
  const int n_norm = (mode == 0 ? 8192 : M_TOK) / 16;
  int nA = 0, nB = 0;
  if (with_w) {
    if (mode == 0) { nA = (DM / 64) * (LDP / 64); nB = (DM / 64) * (DM / 64); }
    else { nA = 0; nB = (DFF / 64) * (DM / 64); }
  }
  const int n_rope = (with_w && mode == 0 && l == 0) ? (M_TOK * 8 / NT) : 0;
  const int total = n_norm + nA + nB + n_rope;
  u16* h = p.inter;
  const float* xsrc = (l == 0 && mode == 0) ? p.x : p.xres;
  for (int t = obid(); t < total; t += gridDim.x) {
    if (t < n_norm) {
      if (mode == 0) norm_task(xsrc + (size_t)half * 8192 * DM, p.norm_mix + l * DM, h, nullptr, t);
      else norm_task(p.xres, p.norm_ffn + l * DM, h, nullptr, t);
    } else if (t < n_norm + nA) {
      if (mode == 0) wconv_task(p.w_in + (size_t)l * DM * INW, DM, INW, LDP, p.WA, t - n_norm, smem);
      else wconv_task(p.w_up + (size_t)l * DM * 2 * DFF, DM, 2 * DFF, 2 * DFF, p.WA, t - n_norm, smem, true);
    } else if (t < n_norm + nA + nB) {
      if (mode == 0) wconv_task(p.w_o + (size_t)l * DM * DM, DM, DM, DM, p.WB, t - n_norm - nA, smem);
      else wconv_task(p.w_down + (size_t)l * DFF * DM, DFF, DM, DM, p.WB, t - n_norm - nA, smem);
    } else {
      const int idx = (t - n_norm - nA - nB) * NT + otid();
      const int tok = idx >> 3, i = idx & 7;
      const float invf[8] = {1.0f, 0.1939227432012558f, 0.03760603070259094f, 0.007292664609849453f, 0.0014142135623842478f,
                             0.00027424818836152554f, 5.318296098266728e-05f, 1.0313386155758053e-05f};
      float fr = invf[0];
#pragma unroll
      for (int q = 1; q < 8; ++q) fr = (i == q) ? invf[q] : fr;
      const float ang = (float)p.pos[tok] * fr;
      const float kq = rintf(ang * 0.15915494309189535f);
      float rr = fmaf(-kq, 6.2831854820251465f, ang); rr = fmaf(-kq, -1.7484555314695172e-07f, rr);
      float sn, cs; sn = __sinf(rr); cs = __cosf(rr);
      p.rope[tok * 16 + i] = cs; p.rope[tok * 16 + 8 + i] = sn;
    }
  }
}

__device__ __forceinline__ float softplus_f(float x) { return fmaxf(x, 0.f) + log1pf(__expf(-fabsf(x))); }

__device__ void dn_local_task(const Params& p, int l, int task, unsigned char* smem) {
  const int b = task >> 7, h = (task >> 5) & 3, n = task & 31;
  int tid_ = otid();
  const int tid = tid_, lane = tid & 63, wid = tid >> 6;
  const size_t rowbase = (size_t)b * SEQ + n * 64;
  u16* qn_s = (u16*)smem;
  u16* kn_s = qn_s + 64 * 136;
  u16* v_s = kn_s + 64 * 136;
  float* A_f = (float*)(smem + 52224);
  float* A_b = (float*)smem;
  float* sm = (float*)(smem + 68608);
  float* gcs = sm; float* bts = sm + 128;
  __syncthreads();
  {
    const size_t chunk_id = (size_t)b * 32 + n;
    const int ch = tid & 15, r0 = tid >> 4;
#pragma unroll
    for (int part = 0; part < 3; ++part) {
      const int hc = part * 512 + h * 128 + ch * 8;
      const float* cw = p.conv_qkv + (size_t)l * 3 * 1536 + hc;
      u32x4 xm[4], x0[4], xp[4];
#pragma unroll
      for (int k = 0; k < 4; ++k) {
        const int r = k * 16 + r0;
        const u16* pc = p.proj + (rowbase + r) * LDP + C_QDN + hc;
        const u16* pm = (r == 0) ? (n == 0 ? pc : p.halo + ((chunk_id - 1) * 2 + 1) * 1536 + hc) : pc - LDP;
        const u16* pp = (r == 63) ? (n == 31 ? pc : p.halo + ((chunk_id + 1) * 2 + 0) * 1536 + hc) : pc + LDP;
        xm[k] = ldu4(pm); x0[k] = ldu4(pc); xp[k] = ldu4(pp);
      }
      float w0[8], w1[8], w2[8];
#pragma unroll
      for (int e4 = 0; e4 < 2; ++e4) {
        const f32x4 a0 = *reinterpret_cast<const f32x4*>(cw + e4 * 4), a1 = *reinterpret_cast<const f32x4*>(cw + 1536 + e4 * 4), a2 = *reinterpret_cast<const f32x4*>(cw + 3072 + e4 * 4);
#pragma unroll
        for (int e = 0; e < 4; ++e) { w0[e4 * 4 + e] = a0[e]; w1[e4 * 4 + e] = a1[e]; w2[e4 * 4 + e] = a2[e]; }
      }
      u16* dbase = (part == 0 ? qn_s : (part == 1 ? kn_s : v_s)) + ch * 8;
#pragma unroll
      for (int k = 0; k < 4; ++k) {
        const int r = k * 16 + r0;
        const float mz = (r == 0 && n == 0) ? 0.f : 1.f, pz = (r == 63 && n == 31) ? 0.f : 1.f;
        float fm[8], f0[8], fp[8], o[8];
        unpack8(xm[k], fm); unpack8(x0[k], f0); unpack8(xp[k], fp);
        float ss = 0.f;
#pragma unroll
        for (int e = 0; e < 8; ++e) {
          float a = w1[e] * f0[e] + mz * (w0[e] * fm[e]) + pz * (w2[e] * fp[e]);
          a = silu_f(a);
          o[e] = a; ss += a * a;
        }
        ss += __shfl_xor(ss, 1); ss += __shfl_xor(ss, 2); ss += __shfl_xor(ss, 4); ss += __shfl_xor(ss, 8);
        float sc = 1.f;
        if (part == 0) sc = rsqrtf(ss + EPS) * 0.08838834764831845f;
        else if (part == 1) sc = rsqrtf(ss + EPS);
#pragma unroll
        for (int e = 0; e < 8; ++e) o[e] *= sc;
        *reinterpret_cast<u32x4*>(dbase + r * 136) = pack8(o);
      }
    }
  }
  if (wid < 2) {
    const int dir = wid;
    const int c = dir ? 63 - lane : lane;
    const u16* rp = p.proj + (rowbase + c) * LDP;
    const float a = bf2f(rp[(dir ? C_AB : C_AF) + h]);
    const float bl = bf2f(rp[(dir ? C_BB : C_BF) + h]);
    const float alog = dir ? p.a_log_b[l * 4 + h] : p.a_log_f[l * 4 + h];
    const float dtb = dir ? p.dt_bias_b[l * 4 + h] : p.dt_bias_f[l * 4 + h];
    float g = -__expf(alog) * softplus_f(a + dtb);
    const float beta = 1.f / (1.f + __expf(-bl));
#pragma unroll
    for (int o = 1; o < 64; o <<= 1) { const float t = __shfl_up(g, o); if (lane >= o) g += t; }
    gcs[dir * 64 + lane] = g; bts[dir * 64 + lane] = beta; sm[256 + dir * 64 + lane] = beta * __expf(g);
    const float glast = __shfl(g, 63);
    float* ge = p.gexp + ((((size_t)b * 4 + h) * 2 + dir) * 32 + n) * 192;
    ge[lane] = __expf(g); ge[64 + lane] = __expf(glast - g);
    if (lane == 0) ge[128] = __expf(glast);
  }
  __syncthreads();
  {
#pragma unroll
    for (int it = 0; it < 4; ++it) {
      const int q = tid + 256 * it, r = q >> 4, ch = q & 15;
      *reinterpret_cast<u32x4*>(p.proj + (rowbase + r) * LDP + C_QDN + h * 128 + ch * 8) = *reinterpret_cast<const u32x4*>(qn_s + r * 136 + ch * 8);
    }
#pragma unroll
    for (int it = 0; it < 4; ++it) {
      const int q = tid + 256 * it, kk = q >> 3, c0 = (q & 7) * 8;
      float f[8];
#pragma unroll
      for (int e = 0; e < 8; ++e) f[e] = bf2f(kn_s[(c0 + e) * 136 + kk]);
      *reinterpret_cast<u32x4*>(p.proj + (rowbase + (kk >> 1)) * LDP + C_KDN + h * 128 + (kk & 1) * 64 + c0) = pack8(f);
    }
  }
  const int fr = lane & 15, fq = lane >> 4;
  f32x4 kk[4], qk[4];
#pragma unroll
  for (int jt = 0; jt < 4; ++jt) { kk[jt] = (f32x4){0.f, 0.f, 0.f, 0.f}; qk[jt] = (f32x4){0.f, 0.f, 0.f, 0.f}; }
#pragma unroll
  for (int ks = 0; ks < 4; ++ks) {
    const bf16x8 bk = ld8(kn_s + (16 * wid + fr) * 136 + ks * 32 + fq * 8);
    const bf16x8 bq = ld8(qn_s + (16 * wid + fr) * 136 + ks * 32 + fq * 8);
#pragma unroll
    for (int jt = 0; jt < 4; ++jt) {
      const bf16x8 a = ld8(kn_s + (16 * jt + fr) * 136 + ks * 32 + fq * 8);
      kk[jt] = mfma16(a, bk, kk[jt]);
      qk[jt] = mfma16(a, bq, qk[jt]);
    }
  }
  __syncthreads();
  u16* blk = p.inter + (size_t)task * 32768;
  {
    const int i = 16 * wid + fr, ib = 63 - i;
    const float gfi = gcs[i], gbi = gcs[64 + ib], bfi = bts[i], bbi = bts[64 + ib];
#pragma unroll
    for (int jt = 0; jt < 4; ++jt) {
      const int j0 = 16 * jt + fq * 4;
      f32x4 af, ab, qf, qb;
#pragma unroll
      for (int e = 0; e < 4; ++e) {
        const int j = j0 + e, jb = 63 - j;
        const float df = (i >= j) ? __expf(gfi - gcs[j]) : 0.f;
        const float db = (ib >= jb) ? __expf(gbi - gcs[64 + jb]) : 0.f;
        af[e] = (i > j) ? bfi * kk[jt][e] * df : 0.f;
        qf[e] = qk[jt][e] * df;
        ab[3 - e] = (ib > jb) ? bbi * kk[jt][e] * db : 0.f;
        qb[3 - e] = qk[jt][e] * db;
      }
      *reinterpret_cast<f32x4*>(A_f + i * 64 + j0) = af;
      *reinterpret_cast<f32x4*>(A_b + ib * 64 + (60 - j0)) = ab;
      u32x2 w; w.x = pk_bf16(qf[0], qf[1]); w.y = pk_bf16(qf[2], qf[3]);
      *reinterpret_cast<u32x2*>(blk + 24576 + i * 64 + j0) = w;
      w.x = pk_bf16(qb[0], qb[1]); w.y = pk_bf16(qb[2], qb[3]);
      *reinterpret_cast<u32x2*>(blk + 28672 + ib * 64 + (60 - j0)) = w;
    }
  }
  __syncthreads();
#ifndef NOSOLVE
  {
    const int col = tid & 127; const bool isW = tid >= 128;
    const u16* src = (isW ? kn_s : v_s) + col;
    const float* scb = isW ? (sm + 256) : bts;
#pragma unroll 1
    for (int dir = 0; dir < 2; ++dir) {
      int dsel = dir; asm volatile("" : "+v"(dsel));
      const float* Am = (const float*)(smem + (dsel ? 0 : 52224));
      const float* scp = scb + dsel * 64;
      const u16* sp = src + (dsel ? 63 * 136 : 0);
      const int sstride = dsel ? -136 : 136;
      u16* dstW = blk + (dsel ? 16384 : 0) + col;
      u16* dstU = dsel ? (blk + 8192 + col) : (p.proj + rowbase * LDP + C_VDN + h * 128 + col);
      u16* dst = isW ? dstW : dstU;
      const int ld = (isW || dsel) ? 128 : LDP;
      float x[64];
      const float* Al = Am + (tid & 63);
      float arow_n = Al[64];
#pragma unroll
      for (int i = 0; i < 64; ++i) {
        float a0 = scp[i] * bf2f(*sp), a1 = 0.f, a2 = 0.f, a3 = 0.f;
        sp += sstride;
        const int arow = __float_as_int(arow_n);
        if (i + 1 < 64 && i >= 1) arow_n = Al[(i + 1) * 64];
#pragma unroll
        for (int j = 0; j < i; ++j) {
          int stmp;
          if ((j & 3) == 0) asm volatile("v_readlane_b32 %1, %2, %3\n\tv_fma_f32 %0, -%1, %4, %0" : "+v"(a0), "=&s"(stmp) : "v"(arow), "n"(j), "v"(x[j]));
          else if ((j & 3) == 1) asm volatile("v_readlane_b32 %1, %2, %3\n\tv_fma_f32 %0, -%1, %4, %0" : "+v"(a1), "=&s"(stmp) : "v"(arow), "n"(j), "v"(x[j]));
          else if ((j & 3) == 2) asm volatile("v_readlane_b32 %1, %2, %3\n\tv_fma_f32 %0, -%1, %4, %0" : "+v"(a2), "=&s"(stmp) : "v"(arow), "n"(j), "v"(x[j]));
          else asm volatile("v_readlane_b32 %1, %2, %3\n\tv_fma_f32 %0, -%1, %4, %0" : "+v"(a3), "=&s"(stmp) : "v"(arow), "n"(j), "v"(x[j]));
        }
        x[i] = (a0 + a1) + (a2 + a3);
      }
#pragma unroll
      for (int i = 0; i < 64; ++i) { *dst = f2bf(x[i]); dst += ld; }
    }
  }
#endif
}

struct ScanA { bf16x8 w[4]; u16 u[2][4]; float egl[4]; };
struct ScanB { bf16x8 qn[4], qk[2], kt[2][2]; float eg, gl; };

__device__ __forceinline__ void scan_loadA(const Params& p, int b, int h, int dir, int slice, int s, int wid, int lane, ScanA& L) {
  const int n = dir ? 31 - s : s;
  const int fr = lane & 15, fq = lane >> 4;
  const size_t rowbase = (size_t)b * SEQ + n * 64;
  const u16* blk = p.inter + ((size_t)(b * 4 + h) * 32 + n) * 32768;
  const int cp = 16 * wid + fr;
  const u16* Wp = blk + (dir ? 16384 : 0) + cp * 128 + fq * 8;
#pragma unroll
  for (int ks = 0; ks < 4; ++ks) L.w[ks] = ld8(Wp + ks * 32);
  const float* ge = p.gexp + ((((size_t)b * 4 + h) * 2 + dir) * 32 + n) * 192;
#pragma unroll
  for (int j = 0; j < 4; ++j) L.egl[j] = ge[64 + 16 * wid + fq * 4 + j];
#pragma unroll
  for (int nt = 0; nt < 2; ++nt)
#pragma unroll
    for (int j = 0; j < 4; ++j) {
      const int c2 = 16 * wid + fq * 4 + j, col = slice * 32 + nt * 16 + fr;
      L.u[nt][j] = dir ? blk[8192 + c2 * 128 + col] : p.proj[(rowbase + c2) * LDP + C_VDN + h * 128 + col];
    }
}
__device__ __forceinline__ void scan_loadB(const Params& p, int b, int h, int dir, int s, int wid, int lane, ScanB& L) {
  const int n = dir ? 31 - s : s;
  const int fr = lane & 15, fq = lane >> 4;
  const size_t rowbase = (size_t)b * SEQ + n * 64;
  const u16* blk = p.inter + ((size_t)(b * 4 + h) * 32 + n) * 32768;
  const int cp = 16 * wid + fr;
  const int corig = dir ? 63 - cp : cp;
  const u16* Qp = p.proj + (rowbase + corig) * LDP + C_QDN + h * 128 + fq * 8;
  const u16* QKp = blk + (dir ? 28672 : 24576) + cp * 64 + fq * 8;
#pragma unroll
  for (int ks = 0; ks < 4; ++ks) L.qn[ks] = ld8(Qp + ks * 32);
#pragma unroll
  for (int ks = 0; ks < 2; ++ks) L.qk[ks] = ld8(QKp + ks * 32);
#pragma unroll
  for (int t = 0; t < 2; ++t) {
    const int kk = (2 * wid + t) * 16 + fr;
    const u16* Kp = p.proj + (rowbase + (kk >> 1)) * LDP + C_KDN + h * 128 + (kk & 1) * 64 + fq * 8;
#pragma unroll
    for (int ks = 0; ks < 2; ++ks) L.kt[t][ks] = ld8(Kp + ks * 32);
  }
  const float* ge = p.gexp + ((((size_t)b * 4 + h) * 2 + dir) * 32 + n) * 192;
  L.eg = ge[cp];
  L.gl = ge[128];
}

__device__ __forceinline__ void scan_step(const Params& p, int b, int h, int dir, int slice, int s, int wid, int lane,
                                          u16* ST0, u16* vnT, u16* vnsT, f32x4 (&S)[2][2],
                                          const ScanA& cur, const ScanB& cb, ScanA& nxt, ScanB& cbn) {
  const int fr = lane & 15, fq = lane >> 4;
  if (s + 1 < 32) { scan_loadA(p, b, h, dir, slice, s + 1, wid, lane, nxt); scan_loadB(p, b, h, dir, s + 1, wid, lane, cbn); }
  const u16* STc = ST0 + (s & 1) * 32 * 136;
  u16* STn = ST0 + ((s + 1) & 1) * 32 * 136;
  const int n = dir ? 31 - s : s;
  const size_t rowbase = (size_t)b * SEQ + n * 64;
  f32x4 vn[2];
#pragma unroll
  for (int nt = 0; nt < 2; ++nt) {
    f32x4 acc = (f32x4){0.f, 0.f, 0.f, 0.f};
#pragma unroll
    for (int ks = 0; ks < 4; ++ks) acc = mfma16(cur.w[ks], ld8(STc + (nt * 16 + fr) * 136 + ks * 32 + fq * 8), acc);
#pragma unroll
    for (int j = 0; j < 4; ++j) vn[nt][j] = bf2f(cur.u[nt][j]) - acc[j];
  }
#pragma unroll
  for (int nt = 0; nt < 2; ++nt) {
    const int nn = nt * 16 + fr, c0 = 16 * wid + fq * 4;
    u32x2 w; w.x = pk_bf16(vn[nt][0], vn[nt][1]); w.y = pk_bf16(vn[nt][2], vn[nt][3]);
    *reinterpret_cast<u32x2*>(vnT + nn * 72 + c0) = w;
    const float s0 = vn[nt][0] * cur.egl[0], s1 = vn[nt][1] * cur.egl[1], s2 = vn[nt][2] * cur.egl[2], s3 = vn[nt][3] * cur.egl[3];
    if (dir) { w.x = pk_bf16(s3, s2); w.y = pk_bf16(s1, s0); *reinterpret_cast<u32x2*>(vnsT + nn * 72 + (60 - c0)) = w; }
    else { w.x = pk_bf16(s0, s1); w.y = pk_bf16(s2, s3); *reinterpret_cast<u32x2*>(vnsT + nn * 72 + c0) = w; }
  }
  __syncthreads();
#pragma unroll
  for (int nt = 0; nt < 2; ++nt) {
    f32x4 a1 = (f32x4){0.f, 0.f, 0.f, 0.f}, a2 = (f32x4){0.f, 0.f, 0.f, 0.f};
#pragma unroll
    for (int ks = 0; ks < 4; ++ks) a1 = mfma16(ld8(STc + (nt * 16 + fr) * 136 + ks * 32 + fq * 8), cb.qn[ks], a1);
#pragma unroll
    for (int ks = 0; ks < 2; ++ks) a2 = mfma16(ld8(vnT + (nt * 16 + fr) * 72 + ks * 32 + fq * 8), cb.qk[ks], a2);
    const int cp = 16 * wid + fr, col = slice * 32 + nt * 16 + fq * 4;
    u32x2 w; w.x = pk_bf16(a1[0] * cb.eg + a2[0], a1[1] * cb.eg + a2[1]); w.y = pk_bf16(a1[2] * cb.eg + a2[2], a1[3] * cb.eg + a2[3]);
    u16* op = dir ? (p.inter + ((size_t)(b * 4 + h) * 32 + n) * 32768 + 8192 + cp * 128 + col)
                  : (p.proj + (rowbase + cp) * LDP + C_VDN + h * 128 + col);
    *reinterpret_cast<u32x2*>(op) = w;
  }
#pragma unroll
  for (int t = 0; t < 2; ++t)
#pragma unroll
    for (int nt = 0; nt < 2; ++nt) {
      f32x4 acc = S[t][nt] * cb.gl;
#pragma unroll
      for (int ks = 0; ks < 2; ++ks) acc = mfma16(cb.kt[t][ks], ld8(vnsT + (nt * 16 + fr) * 72 + ks * 32 + fq * 8), acc);
      S[t][nt] = acc;
      u32x2 w; w.x = pk_bf16(acc[0], acc[1]); w.y = pk_bf16(acc[2], acc[3]);
      *reinterpret_cast<u32x2*>(STn + (nt * 16 + fr) * 136 + (2 * wid + t) * 16 + fq * 4) = w;
    }
  __syncthreads();
}

__device__ void scan_task(const Params& p, int sid, unsigned char* smem) {
  const int b = sid >> 5, h = (sid >> 3) & 3, dir = (sid >> 2) & 1, slice = sid & 3;
  int tid_ = otid();
  const int tid = tid_, lane = tid & 63, wid = tid >> 6;
  u16* ST0 = (u16*)smem;
  u16* vnT = ST0 + 2 * 32 * 136;
  u16* vnsT = vnT + 32 * 72;
  __syncthreads();
  for (int i = tid; i < 32 * 136 / 2; i += NT) reinterpret_cast<unsigned*>(ST0)[i] = 0u;
  f32x4 S[2][2];
#pragma unroll
  for (int a = 0; a < 2; ++a)
#pragma unroll
    for (int c = 0; c < 2; ++c) S[a][c] = (f32x4){0.f, 0.f, 0.f, 0.f};
  ScanA a0, a1;
  ScanB b0, b1;
  scan_loadA(p, b, h, dir, slice, 0, wid, lane, a0);
  scan_loadB(p, b, h, dir, 0, wid, lane, b0);
  __syncthreads();
#pragma unroll 1
  for (int s = 0; s < 32; s += 2) {
    scan_step(p, b, h, dir, slice, s, wid, lane, ST0, vnT, vnsT, S, a0, b0, a1, b1);
    scan_step(p, b, h, dir, slice, s + 1, wid, lane, ST0, vnT, vnsT, S, a1, b1, a0, b0);
  }
}

__device__ void attn_task(const Params& p, int aid, int half, unsigned char* smem) {
  const int b = aid / 384, rem = aid % 384, pt = rem >> 7, rem2 = rem & 127, h = rem2 >> 5, q = rem2 & 31;
  const int dl = pt == 0 ? 1 : (pt == 1 ? 4 : 16);
  const int L = SEQ / dl, nbl = L / 64;
  const int r = q / nbl, nb = q % nbl;
  int tid_ = otid();
  const int tid = tid_, lane = tid & 63, wid = tid >> 6, fr = lane & 15, fq = lane >> 4;
  u16* Qs = (u16*)smem;
  u16* Ks = Qs + 64 * 72;
  u16* VT = Ks + 192 * 72;
  u16* Ps = Ks;
  const size_t tokbase = (size_t)b * SEQ;
  const int cq = C_QC + pt * 256 + h * 64, ck = C_KC + pt * 256 + h * 64, cv = C_VC + pt * 256 + h * 64;
  __syncthreads();
  {
    const int ch = tid & 7, rb = tid >> 3;
    u32x4 qk[8], vv[6];
#pragma unroll
    for (int k = 0; k < 8; ++k) {
      const int row = rb + 32 * k;
      const int i = (k < 2) ? nb * 64 + row : nb * 64 - 128 + row;
      qk[k] = (u32x4){0u, 0u, 0u, 0u};
      if (i >= 0 && i < L) qk[k] = ldu4(p.proj + (tokbase + (size_t)i * dl + r) * LDP + ((k < 2) ? cq : ck) + ch * 8);
    }
#pragma unroll
    for (int k = 0; k < 6; ++k) {
      const int j = nb * 64 - 64 + rb + 32 * k;
      vv[k] = (u32x4){0u, 0u, 0u, 0u};
      if (j >= 0 && j < L) vv[k] = ldu4(p.proj + (tokbase + (size_t)j * dl + r) * LDP + cv + ch * 8);
    }
#pragma unroll
    for (int k = 0; k < 8; ++k) {
      const int row = rb + 32 * k;
      u16* dst = ((k < 2) ? Qs + row * 72 : Ks + (row - 64) * 72) + ch * 8;
      *reinterpret_cast<u32x4*>(dst) = qk[k];
    }
#pragma unroll
    for (int k = 0; k < 6; ++k) {
      const u32x4 w = vv[k];
      u16* d = VT + (ch * 8) * 200 + rb + 32 * k;
      d[0] = (u16)(w.x & 0xffff); d[200] = (u16)(w.x >> 16); d[400] = (u16)(w.y & 0xffff); d[600] = (u16)(w.y >> 16);
      d[800] = (u16)(w.z & 0xffff); d[1000] = (u16)(w.z >> 16); d[1200] = (u16)(w.w & 0xffff); d[1400] = (u16)(w.w >> 16);
    }
  }
  __syncthreads();
  {
    const int e = tid & 7, rb = tid >> 3;
#pragma unroll
    for (int k = 0; k < 8; ++k) {
      const int row = rb + 32 * k;
      const int i = (k < 2) ? nb * 64 + row : nb * 64 - 128 + row;
      if (i >= 0 && i < L) {
        const size_t tok = tokbase + (size_t)i * dl + r;
        const float* rp = p.rope + (tok + (size_t)half * 8192) * 16;
        const float cs = rp[e], sn = rp[8 + e];
        u16* buf = (k < 2) ? Qs + row * 72 : Ks + (row - 64) * 72;
        const float x1 = bf2f(buf[e]), x2 = bf2f(buf[8 + e]);
        buf[e] = f2bf(x1 * cs - x2 * sn); buf[8 + e] = f2bf(x2 * cs + x1 * sn);
      }
    }
  }
  __syncthreads();
  f32x4 sc[12];
  {
    const bf16x8 q0 = ld8(Qs + (16 * wid + fr) * 72 + fq * 8), q1 = ld8(Qs + (16 * wid + fr) * 72 + 32 + fq * 8);
#pragma unroll
    for (int kt = 0; kt < 12; ++kt) {
      f32x4 a = (f32x4){0.f, 0.f, 0.f, 0.f};
      a = mfma16(ld8(Ks + (kt * 16 + fr) * 72 + fq * 8), q0, a);
      a = mfma16(ld8(Ks + (kt * 16 + fr) * 72 + 32 + fq * 8), q1, a);
      sc[kt] = a;
    }
  }
  const int qi = nb * 64 + 16 * wid + fr;
  float mx = -3.0e38f;
#pragma unroll
  for (int kt = 0; kt < 12; ++kt)
#pragma unroll
    for (int e = 0; e < 4; ++e) {
      const int j = nb * 64 - 64 + kt * 16 + fq * 4 + e;
      const int d = qi - j;
      const bool valid = (j >= 0) && (j < L) && (d <= 64) && (d >= -64);
      const float s = valid ? sc[kt][e] * 0.125f : -1e30f;
      sc[kt][e] = s; mx = fmaxf(mx, s);
    }
  mx = fmaxf(mx, __shfl_xor(mx, 16)); mx = fmaxf(mx, __shfl_xor(mx, 32));
  float den = 0.f;
#pragma unroll
  for (int kt = 0; kt < 12; ++kt)
#pragma unroll
    for (int e = 0; e < 4; ++e) { const float pe = __expf(sc[kt][e] - mx); sc[kt][e] = pe; den += pe; }
  den += __shfl_xor(den, 16); den += __shfl_xor(den, 32);
  __syncthreads();
#pragma unroll
  for (int kt = 0; kt < 12; ++kt) {
    u32x2 w; w.x = pk_bf16(sc[kt][0], sc[kt][1]); w.y = pk_bf16(sc[kt][2], sc[kt][3]);
    *reinterpret_cast<u32x2*>(Ps + (16 * wid + fr) * 200 + kt * 16 + fq * 4) = w;
  }
  __syncthreads();
  const float inv = 1.f / den;
  const size_t tokq = tokbase + (size_t)qi * dl + r;
#pragma unroll
  for (int dt = 0; dt < 4; ++dt) {
    f32x4 a = (f32x4){0.f, 0.f, 0.f, 0.f};
#pragma unroll
    for (int ks = 0; ks < 6; ++ks) a = mfma16(ld8(VT + (dt * 16 + fr) * 200 + ks * 32 + fq * 8), ld8(Ps + (16 * wid + fr) * 200 + ks * 32 + fq * 8), a);
    u32x2 w; w.x = pk_bf16(a[0] * inv, a[1] * inv); w.y = pk_bf16(a[2] * inv, a[3] * inv);
    *reinterpret_cast<u32x2*>(p.proj + tokq * LDP + cq + dt * 16 + fq * 4) = w;
  }
  if (fq == 0) p.lse[((size_t)pt * 8192 + tokq) * 4 + h] = mx + __logf(den);
}

__device__ void phase_scan_attn(const Params& p, int l, int half, unsigned char* smem) {
  const int bi = obid(), G = gridDim.x;
  const int nscan_blocks = G >= 256 ? 128 : G / 2;
  if (bi < nscan_blocks) {
    for (int t = bi; t < 128; t += nscan_blocks) {
      const int sid = (t & 7) * 16 + (t >> 3);
      scan_task(p, sid, smem);
    }
  } else {
    const int na = G - nscan_blocks;
    for (int t = bi - nscan_blocks; t < 1536; t += na) attn_task(p, t, half, smem);
    if (half == 0) {
      const float* xsrc = (l == 0) ? p.x : p.xres;
      u16* h1 = p.proj + (size_t)8192 * LDP;
      for (int t = bi - nscan_blocks; t < 8192 / 16; t += na) norm_task(xsrc + (size_t)8192 * DM, p.norm_mix + l * DM, h1, nullptr, t);
    } else {
      for (int t = bi - nscan_blocks; t < (DM / 64) * (2 * DFF / 64); t += na)
        wconv_task(p.w_up + (size_t)l * DM * 2 * DFF, DM, 2 * DFF, 2 * DFF, p.WA, t, smem, true);
    }
  }
}

__device__ void combine_task(const Params& p, int l, int task) {
  const int lane = otid() & 63, wid = otid() >> 6;
  const int g16 = lane >> 4;
  u32x2 oa[4], oc[4]; u32x4 ob4[4];
#pragma unroll
  for (int rr = 0; rr < 4; ++rr) {
    const size_t row = (size_t)task * 16 + wid * 4 + rr;
    const int t = (int)(row & (SEQ - 1));
    const u16* rp = p.proj + row * LDP;
    float ya[4];
    {
      const int c = 4 * lane;
      const float* cw = p.conv_a + (size_t)l * 3 * 256 + c;
      float z[4] = {0.f, 0.f, 0.f, 0.f};
#pragma unroll
      for (int i = 0; i < 3; ++i) {
        const int tt = t + i - 1;
        if (tt < 0 || tt >= SEQ) continue;
        const u16* r2 = rp + (ptrdiff_t)(i - 1) * LDP;
        const u32x2 xa = *reinterpret_cast<const u32x2*>(r2 + c), gc = *reinterpret_cast<const u32x2*>(r2 + 512 + c);
        const f32x4 w = *reinterpret_cast<const f32x4*>(cw + i * 256);
        z[0] += w[0] * bflo(xa.x) * bflo(gc.x); z[1] += w[1] * bfhi(xa.x) * bfhi(gc.x);
        z[2] += w[2] * bflo(xa.y) * bflo(gc.y); z[3] += w[3] * bfhi(xa.y) * bfhi(gc.y);
      }
      const u32x2 gb = *reinterpret_cast<const u32x2*>(rp + 256 + c);
      z[0] *= bflo(gb.x); z[1] *= bfhi(gb.x); z[2] *= bflo(gb.y); z[3] *= bfhi(gb.y);
      float ss = z[0] * z[0] + z[1] * z[1] + z[2] * z[2] + z[3] * z[3];
#pragma unroll
      for (int o = 1; o < 16; o <<= 1) ss += __shfl_xor(ss, o);
      const float rs = rsqrtf(ss * (1.f / 64.f) + EPS);
      const f32x4 g = *reinterpret_cast<const f32x4*>(p.norm_a + l * 256 + c);
#pragma unroll
      for (int e = 0; e < 4; ++e) ya[e] = z[e] * rs * g[e];
    }
    float yb[8];
    {
      const int c = 8 * lane, hh = g16, cc = c & 127;
      const int n = t >> 6, ci = t & 63;
      float of[8], ob[8], gt[8];
      unpack8(ldu4(rp + C_VDN + c), of);
      const u16* blk = p.inter + ((size_t)((row >> 11) * 4 + hh) * 32 + n) * 32768;
      unpack8(ldu4(blk + 8192 + (63 - ci) * 128 + cc), ob);
      unpack8(ldu4(rp + C_GATE + c), gt);
      float ss = 0.f;
#pragma unroll
      for (int e = 0; e < 8; ++e) { of[e] += ob[e]; ss += of[e] * of[e]; }
#pragma unroll
      for (int o = 1; o < 16; o <<= 1) ss += __shfl_xor(ss, o);
      const float rs = rsqrtf(ss * (1.f / 128.f) + EPS);
      const float* g = p.norm_dn + l * 128 + cc;
#pragma unroll
      for (int e = 0; e < 8; ++e) yb[e] = of[e] * rs * g[e] * silu_f(gt[e]);
    }
    float yc[4];
    {
      const int c = 4 * lane, hh = g16;
      const float l0 = p.lse[((size_t)0 * 8192 + row) * 4 + hh], l1 = p.lse[((size_t)1 * 8192 + row) * 4 + hh], l2 = p.lse[((size_t)2 * 8192 + row) * 4 + hh];
      const float mxl = fmaxf(l0, fmaxf(l1, l2));
      float a0 = __expf(l0 - mxl), a1 = __expf(l1 - mxl), a2 = __expf(l2 - mxl);
      const float is = 1.f / (a0 + a1 + a2); a0 *= is; a1 *= is; a2 *= is;
      const u32x2 o0 = *reinterpret_cast<const u32x2*>(rp + C_QC + c), o1 = *reinterpret_cast<const u32x2*>(rp + C_QC + 256 + c), o2 = *reinterpret_cast<const u32x2*>(rp + C_QC + 512 + c);
      float o[4];
      o[0] = a0 * bflo(o0.x) + a1 * bflo(o1.x) + a2 * bflo(o2.x); o[1] = a0 * bfhi(o0.x) + a1 * bfhi(o1.x) + a2 * bfhi(o2.x);
      o[2] = a0 * bflo(o0.y) + a1 * bflo(o1.y) + a2 * bflo(o2.y); o[3] = a0 * bfhi(o0.y) + a1 * bfhi(o1.y) + a2 * bfhi(o2.y);
      float ss = o[0] * o[0] + o[1] * o[1] + o[2] * o[2] + o[3] * o[3];
#pragma unroll
      for (int of = 1; of < 16; of <<= 1) ss += __shfl_xor(ss, of);
      const float rs = rsqrtf(ss * (1.f / 64.f) + EPS);
      const f32x4 g = *reinterpret_cast<const f32x4*>(p.norm_c + l * 256 + c);
#pragma unroll
      for (int e = 0; e < 4; ++e) yc[e] = o[e] * rs * g[e];
    }
    oa[rr].x = pk_bf16(ya[0], ya[1]); oa[rr].y = pk_bf16(ya[2], ya[3]);
    ob4[rr] = pack8(yb);
    oc[rr].x = pk_bf16(yc[0], yc[1]); oc[rr].y = pk_bf16(yc[2], yc[3]);
  }
#pragma unroll
  for (int rr = 0; rr < 4; ++rr) {
    u16* yp = p.proj + ((size_t)task * 16 + wid * 4 + rr) * LDP + C_QDN;
    *reinterpret_cast<u32x2*>(yp + 4 * lane) = oa[rr];
    *reinterpret_cast<u32x4*>(yp + 256 + 8 * lane) = ob4[rr];
    *reinterpret_cast<u32x2*>(yp + 768 + 4 * lane) = oc[rr];
  }
}

__device__ void ffn_fix_item(const Params& p, int l, u16* act, int tm, int item) {
  const int cc = item % 352, side = item / 352;
  const int jg = cc * 8, pos = (jg >> 6) * 128 + (jg & 63);
  const int row = tm * 256 + (side ? 255 : 0), tseq = row & (SEQ - 1);
  const u16* ub = p.ubnd + (size_t)tm * 4 * (2 * DFF) + pos;
  const u16* r0; const u16* r1; const u16* r2; bool z0 = false, z2 = false;
  if (side == 0) { r1 = ub; r2 = ub + 2 * DFF; if (tseq == 0) { z0 = true; r0 = ub; } else r0 = ub - (2 * DFF); }
  else { r0 = ub + 2 * (2 * DFF); r1 = ub + 3 * (2 * DFF); if (tseq == SEQ - 1) { z2 = true; r2 = r1; } else r2 = ub + 4 * (2 * DFF); }
  const float* cw = p.conv_ffn + (size_t)l * 3 * 2 * DFF;
  float g[8], v[8];
#pragma unroll
  for (int e = 0; e < 8; ++e) { g[e] = 0.f; v[e] = 0.f; }
#pragma unroll
  for (int i = 0; i < 3; ++i) {
    const u16* rp = i == 0 ? r0 : (i == 1 ? r1 : r2);
    const float mz = ((i == 0 && z0) || (i == 2 && z2)) ? 0.f : 1.f;
    float a[8], bq[8];
    unpack8(ldu4(rp), a); unpack8(ldu4(rp + 64), bq);
    const float* wg = cw + i * 2 * DFF + jg; const float* wv = wg + DFF;
#pragma unroll
    for (int e = 0; e < 8; ++e) { g[e] += mz * (wg[e] * a[e]); v[e] += mz * (wv[e] * bq[e]); }
  }
  float o[8];
#pragma unroll
  for (int e = 0; e < 8; ++e) o[e] = silu_f(g[e]) * v[e];
  *reinterpret_cast<u32x4*>(act + (size_t)row * DFF + jg) = pack8(o);
}

constexpr int STEPS_PER_LAYER = 14;
constexpr int NSTEPS = 2 * STEPS_PER_LAYER + 1;

__device__ void run_step(const Params& p, int step, float* out, unsigned char* smem) {
  if (step == NSTEPS - 1) {
    for (int t = obid(); t < M_TOK / 16; t += gridDim.x) norm_task(p.xres, p.norm_final, nullptr, out, t);
    return;
  }
  const int l = step / STEPS_PER_LAYER, s = step % STEPS_PER_LAYER;
  u16* h = p.inter;
  if (s == 0) {
    phase_norm_w(p, l, 0, 0, true, smem);
  } else if (s < 11) {
    const int half = (s - 1) / 5, q = (s - 1) % 5;
    float* xh = p.xres + (size_t)half * 8192 * DM;
    const float* rin = (l == 0) ? (p.x + (size_t)half * 8192 * DM) : xh;
    const u16* hA = half ? (p.proj + (size_t)8192 * LDP) : h;
    switch (q) {
      case 0: gemm256_phase<EPI_PROJ>(hA, DM, p.WA, 8192, LDP, DM, p.proj, LDP, nullptr, nullptr, p.halo, smem); break;
      case 1: for (int t = obid(); t < 512; t += gridDim.x) dn_local_task(p, l, t, smem); break;
      case 2: phase_scan_attn(p, l, half, smem); break;
      case 3: for (int t = obid(); t < 8192 / 16; t += gridDim.x) combine_task(p, l, t); break;
      default: gemm_phase<EPI_RES>(p.proj + C_QDN, LDP, p.WB, 8192, DM, DM, nullptr, DM, xh, rin, nullptr, smem); break;
    }
  } else if (s == 11) {
    phase_norm_w(p, l, 1, 0, true, smem);
  } else {
    u16* act = p.proj;
    if (s == 12) gemm256_phase<EPI_UPACT>(h, DM, p.WA, M_TOK, 2 * DFF, DM, act, DFF, nullptr, p.conv_ffn + (size_t)l * 3 * 2 * DFF, p.ubnd, smem);
    else {
#pragma unroll 1
      for (int q = obid() >> 3; q < 8 * 8; q += (gridDim.x >> 3)) {
        const int tm = (obid() & 7) * 8 + (q & 7);
#pragma unroll 1
        for (int it = otid(); it < 704; it += NT) ffn_fix_item(p, l, act, tm, it);
      }
      asm volatile("s_waitcnt vmcnt(0)" ::: "memory");
      __syncthreads();
      gemm256_phase<EPI_RES>(act, DFF, p.WB, M_TOK, DM, DFF, nullptr, DM, p.xres, p.xres, nullptr, smem);
    }
  }
}

#define XB_TMO      128
#define XB_XCNT(j)  (256  + 64 * (j))
#define XB_XSUB(j)  (1280 + 64 * (j))
#define XB_XGEN(j)  (2304 + 64 * (j))
#define XB_TOP      3328
#define XB_TOPGEN   3392
#define XCD_BAR_WORDS 3456
#define XB_SPIN_CAP (1u << 18)
#define LAS __attribute__((address_space(3)))

__device__ __forceinline__ unsigned xb_ld(unsigned* p)              { return __hip_atomic_load(p, __ATOMIC_RELAXED, __HIP_MEMORY_SCOPE_AGENT); }
__device__ __forceinline__ unsigned xb_add(unsigned* p, unsigned v) { return __hip_atomic_fetch_add(p, v, __ATOMIC_RELAXED, __HIP_MEMORY_SCOPE_AGENT); }
__device__ __forceinline__ unsigned xb_xcc_id() { return (unsigned)__builtin_amdgcn_s_getreg((3 << 11) | 20) & 0xFu; }
#define XB_SPIN(cond, bar) do { unsigned _sp = 0; while (cond) { __builtin_amdgcn_s_sleep(1); \
    if ((++_sp & 255u) == 0u) { if (xb_ld(&(bar)[XB_TMO])) break; if (_sp > XB_SPIN_CAP) { atomicAdd(&(bar)[XB_TMO], 1u); break; } } } } while (0)

struct XcdBarrier {
    unsigned* bar; unsigned x;
    volatile LAS unsigned* st;
};

__device__ __forceinline__ XcdBarrier xcd_barrier_post(unsigned* bar, volatile LAS unsigned* st) {
    XcdBarrier b; b.bar = bar; b.x = xb_xcc_id(); b.st = st;
    if (threadIdx.x == 0) (void)xb_add(&bar[XB_XCNT(b.x)], 1u);
    return b;
}
__device__ __forceinline__ void xcd_barrier_complete(unsigned* bar, unsigned x, unsigned& nloc, unsigned& nx) {
    const unsigned G = gridDim.x * gridDim.y * gridDim.z;
    unsigned sum, cnt, mine, sp = 0u;
    for (;;) {
        sum = 0u; cnt = 0u; mine = 0u;
#pragma unroll
        for (unsigned j = 0; j < 16; ++j) { const unsigned c = xb_ld(&bar[XB_XCNT(j)]); sum += c; cnt += (c > 0u) ? 1u : 0u; mine = (j == x) ? c : mine; }
        if (sum == G) break;
        __builtin_amdgcn_s_sleep(1);
        if ((++sp & 255u) == 0u) { if (xb_ld(&bar[XB_TMO])) break; if (sp > XB_SPIN_CAP) { atomicAdd(&bar[XB_TMO], 1u); break; } }
    }
    nloc = mine > 0u ? mine : 1u; nx = cnt > 0u ? cnt : 1u;
}

__device__ __forceinline__ void xcd_barrier(const XcdBarrier& b) {
    asm volatile("s_waitcnt vmcnt(0)" ::: "memory");
    __syncthreads();
    if (threadIdx.x == 0) {
        unsigned* bar = b.bar;
        __builtin_amdgcn_s_waitcnt(0);
        unsigned nloc = b.st[0], nx = b.st[1];
        if (nloc == 0u) { xcd_barrier_complete(bar, b.x, nloc, nx); b.st[0] = nloc; b.st[1] = nx; }
        const unsigned old = xb_add(&bar[XB_XSUB(b.x)], 1u);
        const unsigned gen = old / nloc;
        if (old + 1u == (gen + 1u) * nloc) {
            __builtin_amdgcn_fence(__ATOMIC_RELEASE, "agent");
            asm volatile("s_waitcnt vmcnt(0)" ::: "memory");
            const unsigned og = xb_add(&bar[XB_TOP], 1u);
            const unsigned tg = og / nx;
            if (og + 1u == (tg + 1u) * nx) xb_add(&bar[XB_TOPGEN], 1u);
            else XB_SPIN(xb_ld(&bar[XB_TOPGEN]) == tg, bar);
            __builtin_amdgcn_fence(__ATOMIC_ACQUIRE, "agent");
            xb_add(&bar[XB_XGEN(b.x)], 1u);
            asm volatile("s_waitcnt vmcnt(0)" ::: "memory");
        } else {
            XB_SPIN(xb_ld(&bar[XB_XGEN(b.x)]) == gen, bar);
            __builtin_amdgcn_fence(__ATOMIC_ACQUIRE, "agent");
            asm volatile("s_waitcnt vmcnt(0)" ::: "memory");
        }
    }
    __syncthreads();
}


__device__ __forceinline__ void grid_bar(unsigned* ctr, unsigned target) {
  asm volatile("s_waitcnt vmcnt(0)" ::: "memory");
  __syncthreads();
  if (otid() == 0) {
    __builtin_amdgcn_fence(__ATOMIC_RELEASE, "agent");
    asm volatile("s_waitcnt vmcnt(0)" ::: "memory");
    const unsigned grp = obid() & 7u, gsz = gridDim.x >> 3;
    unsigned* cg_ = ctr + 64 * (1 + grp);
    const unsigned old = __hip_atomic_fetch_add(cg_, 1u, __ATOMIC_RELAXED, __HIP_MEMORY_SCOPE_AGENT);
    if (old + 1 == target * gsz) __hip_atomic_fetch_add(ctr, 1u, __ATOMIC_RELAXED, __HIP_MEMORY_SCOPE_AGENT);
    while (__hip_atomic_load(ctr, __ATOMIC_RELAXED, __HIP_MEMORY_SCOPE_AGENT) < target * 8u) { }
    __builtin_amdgcn_fence(__ATOMIC_ACQUIRE, "agent");
  }
  __syncthreads();
}

__global__ void __launch_bounds__(NT, 2) mega_kernel(Params p, int step_lo, int step_hi) {
  extern __shared__ __attribute__((aligned(16))) unsigned char smem[];
  cg::grid_group grid = cg::this_grid();
  __shared__ unsigned xb_words[4];
  if (threadIdx.x == 0) { xb_words[0] = 0u; xb_words[1] = 0u; }
  __syncthreads();
  const XcdBarrier xb = xcd_barrier_post(p.bar, (volatile LAS unsigned*)&xb_words);
  for (int step = step_lo; step < step_hi; ++step) {
    run_step(p, step, (float*)p.out, smem);
    if (step + 1 < step_hi) {
      if (step_hi < 0) grid.sync();
      xcd_barrier(xb);
    }
  }
}

extern "C" void kernel_launch(void* const* d_in, const int* in_sizes, int n_in, void* d_out, int out_size, void* d_ws, size_t ws_size,
                              hipStream_t stream) {
  static int grid_blocks = 0;
  if (!grid_blocks) {
    int dev = 0, cus = 0, per_cu = 0;
    hipGetDevice(&dev);
    hipDeviceGetAttribute(&cus, hipDeviceAttributeMultiprocessorCount, dev);
    hipFuncSetAttribute((const void*)mega_kernel, hipFuncAttributeMaxDynamicSharedMemorySize, SMEM_BYTES);
    hipOccupancyMaxActiveBlocksPerMultiprocessor(&per_cu, mega_kernel, NT, SMEM_BYTES);
    if (per_cu > 2) per_cu = 2;
    if (per_cu < 1) per_cu = 1;
    grid_blocks = cus * per_cu;
    grid_blocks -= grid_blocks % 8;
  }
  Params p{};
  p.x = (const float*)d_in[0]; p.pos = (const int*)d_in[1]; p.norm_mix = (const float*)d_in[2]; p.w_in = (const float*)d_in[3];
  p.conv_a = (const float*)d_in[4]; p.norm_a = (const float*)d_in[5]; p.conv_qkv = (const float*)d_in[6];
  p.a_log_f = (const float*)d_in[7]; p.a_log_b = (const float*)d_in[8]; p.dt_bias_f = (const float*)d_in[9]; p.dt_bias_b = (const float*)d_in[10];
  p.norm_dn = (const float*)d_in[11]; p.norm_c = (const float*)d_in[12]; p.w_o = (const float*)d_in[13]; p.norm_ffn = (const float*)d_in[14];
  p.w_up = (const float*)d_in[15]; p.conv_ffn = (const float*)d_in[16]; p.w_down = (const float*)d_in[17]; p.norm_final = (const float*)d_in[18];
  p.out = (float*)d_out;
  unsigned char* ws = (unsigned char*)d_ws;
  size_t off = 0;
  p.proj = (u16*)(ws + off); off += (size_t)8192 * 3 * DFF * 2;
  p.inter = (u16*)(ws + off); off += (size_t)512 * 65536;
  p.WA = (u16*)(ws + off); off += (size_t)2 * DFF * DM * 2;
  p.WB = (u16*)(ws + off); off += (size_t)DM * DFF * 2;
  p.halo = (u16*)(ws + off); off += (size_t)256 * 1536 * 2;
  p.lse = (float*)(ws + off); off += (size_t)3 * 8192 * 4 * 4;
  p.gexp = (float*)(ws + off); off += (size_t)1024 * 192 * 4;
  p.rope = (float*)(ws + off); off += (size_t)M_TOK * 16 * 4;
  p.xres = (float*)(ws + off); off += (size_t)M_TOK * DM * 4;
  p.bar = (unsigned*)(ws + off); off += 16384;
  p.ubnd = (u16*)(ws + off); off += (size_t)128 * 4 * 2 * DFF * 2;
  if (off > ws_size) { fprintf(stderr, "workspace too small: need %zu have %zu\n", off, ws_size); return; }
#if MEGA
  hipMemsetAsync(p.bar, 0, 16384, stream);
  int lo = 0, hi = NSTEPS;
  void* args[] = {&p, &lo, &hi};
  hipError_t e = hipLaunchCooperativeKernel((const void*)mega_kernel, dim3(grid_blocks), dim3(NT), args, SMEM_BYTES, stream);
  if (e != hipSuccess) fprintf(stderr, "cooperative launch failed: %s (grid %d)\n", hipGetErrorString(e), grid_blocks);
#else
  for (int s = 0; s < NSTEPS; ++s) hipLaunchKernelGGL(mega_kernel, dim3(grid_blocks), dim3(NT), SMEM_BYTES, stream, p, s, s + 1);
#endif
}
```

```cpp
#include <hip/hip_runtime.h>
#include <hip/hip_cooperative_groups.h>
#include <cstdio>
#include <cstdint>
namespace cg = cooperative_groups;

#ifndef MEGA
#define MEGA 1
#endif

typedef unsigned short u16;
typedef short bf16x8 __attribute__((ext_vector_type(8)));
typedef float f32x4 __attribute__((ext_vector_type(4)));
typedef unsigned u32x4 __attribute__((ext_vector_type(4)));
typedef unsigned u32x2 __attribute__((ext_vector_type(2)));

constexpr int NT = 256;
constexpr int M_TOK = 16384, SEQ = 2048, DM = 1024;
constexpr int LDP = 5248;
constexpr int INW = 5136;
constexpr int DFF = 2816;
constexpr int C_QDN = 768, C_KDN = 1280, C_VDN = 1792, C_GATE = 2304, C_BF = 2816, C_BB = 2820, C_AF = 2824, C_AB = 2828;
constexpr int C_QC = 2832, C_KC = 3600, C_VC = 4368;
constexpr float EPS = 1e-6f;
constexpr int SMEM_BYTES = 73728;

struct Params {
  const float* x; const int* pos; const float* norm_mix; const float* w_in; const float* conv_a; const float* norm_a;
  const float* conv_qkv; const float* a_log_f; const float* a_log_b; const float* dt_bias_f; const float* dt_bias_b;
  const float* norm_dn; const float* norm_c; const float* w_o; const float* norm_ffn; const float* w_up; const float* conv_ffn;
  const float* w_down; const float* norm_final;
  float* xres;
  float* out;
  u16* proj;
  u16* inter;
  u16* WA; u16* WB; u16* halo; float* lse; float* gexp; float* rope;
  u16* ubnd;
  unsigned* bar;
};

__device__ __forceinline__ int obid() { int b = __builtin_amdgcn_workgroup_id_x(); asm volatile("" : "+s"(b)); return b; }
__device__ __forceinline__ int otid() { int t = __builtin_amdgcn_workitem_id_x(); asm volatile("" : "+v"(t)); return t; }
typedef float f32x2_t __attribute__((ext_vector_type(2)));
typedef __bf16 bf16x2_t __attribute__((ext_vector_type(2)));
__device__ __forceinline__ unsigned pk_bf16(float lo, float hi) {
  f32x2_t v = {lo, hi};
  bf16x2_t b = __builtin_convertvector(v, bf16x2_t);
  return __builtin_bit_cast(unsigned, b);
}
__device__ __forceinline__ u16 f2bf(float f) { return (u16)(pk_bf16(f, 0.f) & 0xffffu); }
__device__ __forceinline__ float bf2f(u16 h) { return __uint_as_float(((unsigned)h) << 16); }
__device__ __forceinline__ float bflo(unsigned w) { return __uint_as_float(w << 16); }
__device__ __forceinline__ float bfhi(unsigned w) { return __uint_as_float(w & 0xffff0000u); }
__device__ __forceinline__ float silu_f(float x) { return x / (1.f + __expf(-x)); }
__device__ __forceinline__ f32x4 mfma16(bf16x8 a, bf16x8 b, f32x4 c) { return __builtin_amdgcn_mfma_f32_16x16x32_bf16(a, b, c, 0, 0, 0); }
__device__ __forceinline__ bf16x8 ld8(const u16* p) { return *reinterpret_cast<const bf16x8*>(p); }
__device__ __forceinline__ u32x4 ldu4(const u16* p) { return *reinterpret_cast<const u32x4*>(p); }
__device__ __forceinline__ void unpack8(u32x4 w, float* f) {
  f[0] = bflo(w.x); f[1] = bfhi(w.x); f[2] = bflo(w.y); f[3] = bfhi(w.y);
  f[4] = bflo(w.z); f[5] = bfhi(w.z); f[6] = bflo(w.w); f[7] = bfhi(w.w);
}
__device__ __forceinline__ u32x4 pack8(const float* f) {
  u32x4 w; w.x = pk_bf16(f[0], f[1]); w.y = pk_bf16(f[2], f[3]); w.z = pk_bf16(f[4], f[5]); w.w = pk_bf16(f[6], f[7]); return w;
}

constexpr int EPI_PROJ = 0, EPI_RES = 1, EPI_BF16 = 2, EPI_UPACT = 3;
constexpr int GLD = 64;
constexpr int GBUF = 2 * 128 * GLD;

template <int EPI>
__device__ void gemm_phase(const u16* __restrict__ A, int lda, const u16* __restrict__ Bt, int Mrows, int N, int K,
                           u16* Cb, int ldc, float* Cres, const float* Rin, u16* halo, unsigned char* smem) {
  u16* As = (u16*)smem;
  u16* Bs = As + 128 * GLD;
  const int tid = otid(), lane = tid & 63, wid = tid >> 6, wr = wid >> 1, wc = wid & 1;
  const int fr = lane & 15, fq = lane >> 4;
  const int ntm = Mrows / 128, ntn = N / 128, ntiles = ntm * ntn;
  const int nk = K / 64;
  const int xcd = obid() & 7, jb = obid() >> 3, nper = gridDim.x >> 3, tmper = ntm >> 3;
  (void)ntiles;
  for (int q = jb; q < tmper * ntn; q += nper) {
    const int tm = xcd * tmper + (q % tmper), tn = q / tmper;
    const int m0 = tm * 128, n0 = tn * 128;
    f32x4 acc[4][4];
#pragma unroll
    for (int i = 0; i < 4; ++i)
#pragma unroll
      for (int j = 0; j < 4; ++j) acc[i][j] = (f32x4){0.f, 0.f, 0.f, 0.f};
    u32x4 ra0[4], rb0[4], ra1[4], rb1[4];
    const int lrow = tid >> 3, lch = tid & 7;
    const int swc = lch ^ (lrow & 7);
    const u16* Ag = A + (size_t)(m0 + lrow) * lda + lch * 8;
    const u16* Bg = Bt + (size_t)(n0 + lrow) * K + lch * 8;
#define G_LOAD(RA, RB, KT) do { const int ko_ = (KT) * 64; _Pragma("unroll") for (int i = 0; i < 4; ++i) { RA[i] = ldu4(Ag + (size_t)(i * 32) * lda + ko_); RB[i] = ldu4(Bg + (size_t)(i * 32) * K + ko_); } } while (0)
#define G_STORE(RA, RB, ST) do { u16* An_ = As + (ST) * GBUF; u16* Bn_ = Bs + (ST) * GBUF; _Pragma("unroll") for (int i = 0; i < 4; ++i) { \
      *reinterpret_cast<u32x4*>(An_ + (lrow + i * 32) * GLD + swc * 8) = RA[i]; *reinterpret_cast<u32x4*>(Bn_ + (lrow + i * 32) * GLD + swc * 8) = RB[i]; } } while (0)
#define G_COMPUTE(ST) do { const u16* Ac = As + (ST) * GBUF; const u16* Bc = Bs + (ST) * GBUF; _Pragma("unroll") for (int ks = 0; ks < 2; ++ks) { \
      bf16x8 af[4], bfr[4]; _Pragma("unroll") for (int i = 0; i < 4; ++i) { \
        af[i] = ld8(Ac + (wr * 64 + i * 16 + fr) * GLD + (((ks * 4 + fq) ^ (fr & 7)) * 8)); \
        bfr[i] = ld8(Bc + (wc * 64 + i * 16 + fr) * GLD + (((ks * 4 + fq) ^ (fr & 7)) * 8)); } \
      __builtin_amdgcn_s_setprio(1); \
      _Pragma("unroll") for (int mt = 0; mt < 4; ++mt) _Pragma("unroll") for (int nt = 0; nt < 4; ++nt) acc[mt][nt] = mfma16(bfr[nt], af[mt], acc[mt][nt]); \
      __builtin_amdgcn_s_setprio(0); } } while (0)
    G_LOAD(ra0, rb0, 0);
    G_LOAD(ra1, rb1, 1);
    __syncthreads();
    G_STORE(ra0, rb0, 0);
    __syncthreads();
    for (int kt = 0; kt < nk; kt += 2) {
      if (kt + 2 < nk) G_LOAD(ra0, rb0, kt + 2);
      G_COMPUTE(0);
      G_STORE(ra1, rb1, 1);
      __syncthreads();
      if (kt + 3 < nk) G_LOAD(ra1, rb1, kt + 3);
      G_COMPUTE(1);
      if (kt + 2 < nk) G_STORE(ra0, rb0, 0);
      __syncthreads();
    }
#undef G_LOAD
#undef G_STORE
#undef G_COMPUTE
    if (EPI == EPI_UPACT) {
      u16* T = (u16*)smem;
#pragma unroll
      for (int mt = 0; mt < 4; ++mt)
#pragma unroll
        for (int nt = 0; nt < 4; ++nt) {
          const f32x4 v = acc[mt][nt];
          u32x2 w; w.x = pk_bf16(v[0], v[1]); w.y = pk_bf16(v[2], v[3]);
          *reinterpret_cast<u32x2*>(T + (wr * 64 + mt * 16 + fr) * 136 + wc * 64 + nt * 16 + fq * 4) = w;
        }
      __syncthreads();
      const int jc = tid & 7, jg = tn * 64 + jc * 8;
      const float* cw = Rin;
      float wg[3][8], wv[3][8];
#pragma unroll
      for (int i = 0; i < 3; ++i)
#pragma unroll
        for (int e4 = 0; e4 < 2; ++e4) {
          const f32x4 a = *reinterpret_cast<const f32x4*>(cw + i * 2 * DFF + jg + e4 * 4), bq = *reinterpret_cast<const f32x4*>(cw + i * 2 * DFF + DFF + jg + e4 * 4);
#pragma unroll
          for (int e = 0; e < 4; ++e) { wg[i][e4 * 4 + e] = a[e]; wv[i][e4 * 4 + e] = bq[e]; }
        }
#pragma unroll 1
      for (int k = 0; k < 4; ++k) {
        const int t = (tid >> 3) + 32 * k;
        if (t >= 1 && t <= 126) {
          float g[8], vv[8];
#pragma unroll
          for (int e = 0; e < 8; ++e) { g[e] = 0.f; vv[e] = 0.f; }
#pragma unroll
          for (int i = 0; i < 3; ++i) {
            float a[8], bq[8];
            unpack8(*reinterpret_cast<const u32x4*>(T + (t + i - 1) * 136 + jc * 8), a);
            unpack8(*reinterpret_cast<const u32x4*>(T + (t + i - 1) * 136 + 64 + jc * 8), bq);
#pragma unroll
            for (int e = 0; e < 8; ++e) { g[e] += wg[i][e] * a[e]; vv[e] += wv[i][e] * bq[e]; }
          }
          float o[8];
#pragma unroll
          for (int e = 0; e < 8; ++e) o[e] = silu_f(g[e]) * vv[e];
          *reinterpret_cast<u32x4*>(Cb + (size_t)(m0 + t) * ldc + jg) = pack8(o);
        }
        if (t <= 1 || t >= 126) {
          const int slot = (t <= 1) ? t : t - 124;
          u16* ub = halo + (size_t)(tm * 4 + slot) * (2 * DFF) + n0;
          *reinterpret_cast<u32x4*>(ub + jc * 8) = *reinterpret_cast<const u32x4*>(T + t * 136 + jc * 8);
          *reinterpret_cast<u32x4*>(ub + 64 + jc * 8) = *reinterpret_cast<const u32x4*>(T + t * 136 + 64 + jc * 8);
        }
      }
      continue;
    }
    if (EPI == EPI_RES) {
      f32x4 r[4][4];
#pragma unroll
      for (int mt = 0; mt < 4; ++mt)
#pragma unroll
        for (int nt = 0; nt < 4; ++nt) r[mt][nt] = *reinterpret_cast<const f32x4*>(Rin + (size_t)(m0 + wr * 64 + mt * 16 + fr) * ldc + n0 + wc * 64 + nt * 16 + fq * 4);
#pragma unroll
      for (int mt = 0; mt < 4; ++mt)
#pragma unroll
        for (int nt = 0; nt < 4; ++nt) *reinterpret_cast<f32x4*>(Cres + (size_t)(m0 + wr * 64 + mt * 16 + fr) * ldc + n0 + wc * 64 + nt * 16 + fq * 4) = r[mt][nt] + acc[mt][nt];
      continue;
    }
#pragma unroll
    for (int mt = 0; mt < 4; ++mt) {
      const int m = m0 + wr * 64 + mt * 16 + fr;
#pragma unroll
      for (int nt = 0; nt < 4; ++nt) {
        const int n = n0 + wc * 64 + nt * 16 + fq * 4;
        const f32x4 v = acc[mt][nt];
        if (EPI == EPI_RES) {
          float* p = Cres + (size_t)m * ldc + n;
          f32x4 o = *reinterpret_cast<const f32x4*>(Rin + (size_t)m * ldc + n);
          o += v;
          *reinterpret_cast<f32x4*>(p) = o;
        } else {
          u32x2 w; w.x = pk_bf16(v[0], v[1]); w.y = pk_bf16(v[2], v[3]);
          *reinterpret_cast<u32x2*>(Cb + (size_t)m * ldc + n) = w;
          if (EPI == EPI_PROJ) {
            const int mm = m & 63;
            if ((mm == 0 || mm == 63) && n >= C_QDN && n < C_GATE)
              *reinterpret_cast<u32x2*>(halo + (size_t)((m >> 6) * 2 + (mm == 63 ? 1 : 0)) * 1536 + (n - C_QDN)) = w;
          }
        }
      }
    }
  }
}

template <int EPI>
__device__ void gemm256_phase(const u16* __restrict__ A, int lda, const u16* __restrict__ Bt, int Mrows, int N, int K,
                              u16* Cb, int ldc, float* Cres, const float* Rin, u16* halo, unsigned char* smem) {
  u16* As = (u16*)smem;
  u16* Bs = As + 256 * 64;
  const int tid = otid(), lane = tid & 63, wid = tid >> 6, wr = wid >> 1, wc = wid & 1;
  const int fr = lane & 15, fq = lane >> 4;
  const int ntm = Mrows / 256, ntn = N / 128, nk = K / 64;
  const int xcd = obid() & 7, jb = obid() >> 3, nper = gridDim.x >> 3, tmper = ntm >> 3;
  for (int q = jb; q < tmper * ntn; q += nper) {
    const int tm = xcd * tmper + (q % tmper), tn = q / tmper;
    const int m0 = tm * 256, n0 = tn * 128;
    f32x4 acc[8][4];
#pragma unroll
    for (int i = 0; i < 8; ++i)
#pragma unroll
      for (int j = 0; j < 4; ++j) acc[i][j] = (f32x4){0.f, 0.f, 0.f, 0.f};
    u32x4 ra[8], rb[4];
    const int lrow = tid >> 3, lch = tid & 7;
    const int swc = lch ^ (lrow & 7);
    const u16* Ag = A + (size_t)(m0 + lrow) * lda + lch * 8;
    const u16* Bg = Bt + (size_t)(n0 + lrow) * K + lch * 8;
#pragma unroll
    for (int i = 0; i < 8; ++i) ra[i] = ldu4(Ag + (size_t)(i * 32) * lda);
#pragma unroll
    for (int i = 0; i < 4; ++i) rb[i] = ldu4(Bg + (size_t)(i * 32) * K);
    for (int kt = 0; kt < nk; ++kt) {
      __syncthreads();
#pragma unroll
      for (int i = 0; i < 8; ++i) *reinterpret_cast<u32x4*>(As + (lrow + i * 32) * 64 + swc * 8) = ra[i];
#pragma unroll
      for (int i = 0; i < 4; ++i) *reinterpret_cast<u32x4*>(Bs + (lrow + i * 32) * 64 + swc * 8) = rb[i];
      __syncthreads();
      if (kt + 1 < nk) {
        const int ko = (kt + 1) * 64;
#pragma unroll
        for (int i = 0; i < 8; ++i) ra[i] = ldu4(Ag + (size_t)(i * 32) * lda + ko);
#pragma unroll
        for (int i = 0; i < 4; ++i) rb[i] = ldu4(Bg + (size_t)(i * 32) * K + ko);
      }
#pragma unroll
      for (int ks = 0; ks < 2; ++ks) {
        const int sw = ((ks * 4 + fq) ^ (fr & 7)) * 8;
        bf16x8 bfr[4];
#pragma unroll
        for (int i = 0; i < 4; ++i) bfr[i] = ld8(Bs + (wc * 64 + i * 16 + fr) * 64 + sw);
#pragma unroll
        for (int mh = 0; mh < 2; ++mh) {
          bf16x8 af[4];
#pragma unroll
          for (int i = 0; i < 4; ++i) af[i] = ld8(As + (wr * 128 + (mh * 4 + i) * 16 + fr) * 64 + sw);
          __builtin_amdgcn_s_setprio(1);
#pragma unroll
          for (int i = 0; i < 4; ++i)
#pragma unroll
            for (int nt = 0; nt < 4; ++nt) acc[mh * 4 + i][nt] = mfma16(bfr[nt], af[i], acc[mh * 4 + i][nt]);
          __builtin_amdgcn_s_setprio(0);
        }
      }
    }
    if (EPI == EPI_UPACT) {
      u16* T = (u16*)smem;
      __syncthreads();
#pragma unroll
      for (int mt = 0; mt < 8; ++mt)
#pragma unroll
        for (int nt = 0; nt < 4; ++nt) {
          const f32x4 v = acc[mt][nt];
          u32x2 w; w.x = pk_bf16(v[0], v[1]); w.y = pk_bf16(v[2], v[3]);
          *reinterpret_cast<u32x2*>(T + (wr * 128 + mt * 16 + fr) * 136 + wc * 64 + nt * 16 + fq * 4) = w;
        }
      __syncthreads();
      const int jc = tid & 7, jg = tn * 64 + jc * 8;
      const float* cw = Rin;
      float wg[3][8], wv[3][8];
#pragma unroll
      for (int i = 0; i < 3; ++i)
#pragma unroll
        for (int e4 = 0; e4 < 2; ++e4) {
          const f32x4 a = *reinterpret_cast<const f32x4*>(cw + i * 2 * DFF + jg + e4 * 4), bq = *reinterpret_cast<const f32x4*>(cw + i * 2 * DFF + DFF + jg + e4 * 4);
#pragma unroll
          for (int e = 0; e < 4; ++e) { wg[i][e4 * 4 + e] = a[e]; wv[i][e4 * 4 + e] = bq[e]; }
        }
#pragma unroll 1
      for (int k = 0; k < 8; ++k) {
        const int t = (tid >> 3) + 32 * k;
        if (t >= 1 && t <= 254) {
          float g[8], vv[8];
#pragma unroll
          for (int e = 0; e < 8; ++e) { g[e] = 0.f; vv[e] = 0.f; }
#pragma unroll
          for (int i = 0; i < 3; ++i) {
            float a[8], bq[8];
            unpack8(*reinterpret_cast<const u32x4*>(T + (t + i - 1) * 136 + jc * 8), a);
            unpack8(*reinterpret_cast<const u32x4*>(T + (t + i - 1) * 136 + 64 + jc * 8), bq);
#pragma unroll
            for (int e = 0; e < 8; ++e) { g[e] += wg[i][e] * a[e]; vv[e] += wv[i][e] * bq[e]; }
          }
          float o[8];
#pragma unroll
          for (int e = 0; e < 8; ++e) o[e] = silu_f(g[e]) * vv[e];
          *reinterpret_cast<u32x4*>(Cb + (size_t)(m0 + t) * ldc + jg) = pack8(o);
        }
        if (t <= 1 || t >= 254) {
          const int slot = (t <= 1) ? t : t - 252;
          u16* ub = halo + (size_t)(tm * 4 + slot) * (2 * DFF) + n0;
          *reinterpret_cast<u32x4*>(ub + jc * 8) = *reinterpret_cast<const u32x4*>(T + t * 136 + jc * 8);
          *reinterpret_cast<u32x4*>(ub + 64 + jc * 8) = *reinterpret_cast<const u32x4*>(T + t * 136 + 64 + jc * 8);
        }
      }
      continue;
    }
    if (EPI == EPI_RES) {
#pragma unroll
      for (int mh = 0; mh < 2; ++mh) {
        f32x4 r[4][4];
#pragma unroll
        for (int mt = 0; mt < 4; ++mt)
#pragma unroll
          for (int nt = 0; nt < 4; ++nt) r[mt][nt] = *reinterpret_cast<const f32x4*>(Rin + (size_t)(m0 + wr * 128 + (mh * 4 + mt) * 16 + fr) * ldc + n0 + wc * 64 + nt * 16 + fq * 4);
#pragma unroll
        for (int mt = 0; mt < 4; ++mt)
#pragma unroll
          for (int nt = 0; nt < 4; ++nt) *reinterpret_cast<f32x4*>(Cres + (size_t)(m0 + wr * 128 + (mh * 4 + mt) * 16 + fr) * ldc + n0 + wc * 64 + nt * 16 + fq * 4) = r[mt][nt] + acc[mh * 4 + mt][nt];
      }
      continue;
    }
#pragma unroll
    for (int mt = 0; mt < 8; ++mt) {
      const int m = m0 + wr * 128 + mt * 16 + fr;
#pragma unroll
      for (int nt = 0; nt < 4; ++nt) {
        const int n = n0 + wc * 64 + nt * 16 + fq * 4;
        const f32x4 v = acc[mt][nt];
        if (EPI == EPI_RES) {
          float* p = Cres + (size_t)m * ldc + n;
          f32x4 o = *reinterpret_cast<const f32x4*>(Rin + (size_t)m * ldc + n);
          o += v;
          *reinterpret_cast<f32x4*>(p) = o;
        } else {
          u32x2 w; w.x = pk_bf16(v[0], v[1]); w.y = pk_bf16(v[2], v[3]);
          *reinterpret_cast<u32x2*>(Cb + (size_t)m * ldc + n) = w;
          if (EPI == EPI_PROJ) {
            const int mm = m & 63;
            if ((mm == 0 || mm == 63) && n >= C_QDN && n < C_GATE)
              *reinterpret_cast<u32x2*>(halo + (size_t)((m >> 6) * 2 + (mm == 63 ? 1 : 0)) * 1536 + (n - C_QDN)) = w;
          }
        }
      }
    }
  }
}

__device__ void norm_task(const float* src, const float* __restrict__ g, u16* dst, float* dstf, int task) {
  const int lane = otid() & 63, wid = otid() >> 6;
#pragma unroll 1
  for (int rr = 0; rr < 4; ++rr) {
    const int row = task * 16 + wid * 4 + rr;
    const float* s = src + (size_t)row * DM;
    f32x4 v[4]; float ss = 0.f;
#pragma unroll
    for (int i = 0; i < 4; ++i) { v[i] = *reinterpret_cast<const f32x4*>(s + i * 256 + lane * 4); ss += v[i][0] * v[i][0] + v[i][1] * v[i][1] + v[i][2] * v[i][2] + v[i][3] * v[i][3]; }
#pragma unroll
    for (int o = 1; o < 64; o <<= 1) ss += __shfl_xor(ss, o);
    const float rs = rsqrtf(ss * (1.f / DM) + EPS);
#pragma unroll
    for (int i = 0; i < 4; ++i) {
      const f32x4 gg = *reinterpret_cast<const f32x4*>(g + i * 256 + lane * 4);
      f32x4 y; y[0] = v[i][0] * rs * gg[0]; y[1] = v[i][1] * rs * gg[1]; y[2] = v[i][2] * rs * gg[2]; y[3] = v[i][3] * rs * gg[3];
      if (dstf) *reinterpret_cast<f32x4*>(dstf + (size_t)row * DM + i * 256 + lane * 4) = y;
      else { u32x2 w; w.x = pk_bf16(y[0], y[1]); w.y = pk_bf16(y[2], y[3]); *reinterpret_cast<u32x2*>(dst + (size_t)row * DM + i * 256 + lane * 4) = w; }
    }
  }
}

__device__ void wconv_task(const float* __restrict__ W, int K, int N, int Npad, u16* Wt, int task, unsigned char* smem, bool perm = false) {
  float* tl = (float*)smem;
  const int ntn = Npad / 64;
  const int tk = task / ntn, tn = task % ntn;
  const int k0 = tk * 64, n0 = tn * 64, tid = otid();
  __syncthreads();
#pragma unroll
  for (int i = 0; i < 4; ++i) {
    const int k = (tid >> 4) + 16 * i, n4 = (tid & 15) * 4;
    f32x4 v = (f32x4){0.f, 0.f, 0.f, 0.f};
    if (n0 + n4 < N) v = *reinterpret_cast<const f32x4*>(W + (size_t)(k0 + k) * N + n0 + n4);
    tl[k * 65 + n4 + 0] = v[0]; tl[k * 65 + n4 + 1] = v[1]; tl[k * 65 + n4 + 2] = v[2]; tl[k * 65 + n4 + 3] = v[3];
  }
  __syncthreads();
  const int n = tid >> 2, ks = (tid & 3) * 16;
  float f[16];
#pragma unroll
  for (int i = 0; i < 16; ++i) f[i] = tl[(ks + i) * 65 + n];
  const int dn0 = perm ? (n0 < DFF ? (n0 >> 6) * 128 : ((n0 - DFF) >> 6) * 128 + 64) : n0;
  u16* o = Wt + (size_t)(dn0 + n) * K + k0 + ks;
  *reinterpret_cast<u32x4*>(o) = pack8(f);
  *reinterpret_cast<u32x4*>(o + 8) = pack8(f + 8);
}

__device__ void phase_norm_w(const Params& p, int l, int mode, int half, bool with_w, unsigned char* smem) {
  const int n_norm = (mode == 0 ? 8192 : M_TOK) / 16;
  int nA = 0, nB = 0;
  if (with_w) {
    if (mode == 0) { nA = (DM / 64) * (LDP / 64); nB = (DM / 64) * (DM / 64); }
    else { nA = 0; nB = (DFF / 64) * (DM / 64); }
  }
  const int n_rope = (with_w && mode == 0 && l == 0) ? (M_TOK * 8 / NT) : 0;
  const int total = n_norm + nA + nB + n_rope;
  u16* h = p.inter;
  const float* xsrc = (l == 0 && mode == 0) ? p.x : p.xres;
  for (int t = obid(); t < total; t += gridDim.x) {
    if (t < n_norm) {
      if (mode == 0) norm_task(xsrc + (size_t)half * 8192 * DM, p.norm_mix + l * DM, h, nullptr, t);
      else norm_task(p.xres, p.norm_ffn + l * DM, h, nullptr, t);
    } else if (t < n_norm + nA) {
      if (mode == 0) wconv_task(p.w_in + (size_t)l * DM * INW, DM, INW, LDP, p.WA, t - n_norm, smem);
      else wconv_task(p.w_up + (size_t)l * DM * 2 * DFF, DM, 2 * DFF, 2 * DFF, p.WA, t - n_norm, smem, true);
    } else if (t < n_norm + nA + nB) {
      if (mode == 0) wconv_task(p.w_o + (size_t)l * DM * DM, DM, DM, DM, p.WB, t - n_norm - nA, smem);
      else wconv_task(p.w_down + (size_t)l * DFF * DM, DFF, DM, DM, p.WB, t - n_norm - nA, smem);
    } else {
      const int idx = (t - n_norm - nA - nB) * NT + otid();
      const int tok = idx >> 3, i = idx & 7;
      const float invf[8] = {1.0f, 0.1939227432012558f, 0.03760603070259094f, 0.007292664609849453f, 0.0014142135623842478f,
                             0.00027424818836152554f, 5.318296098266728e-05f, 1.0313386155758053e-05f};
      float fr = invf[0];
#pragma unroll
      for (int q = 1; q < 8; ++q) fr = (i == q) ? invf[q] : fr;
      const float ang = (float)p.pos[tok] * fr;
      const float kq = rintf(ang * 0.15915494309189535f);
      float rr = fmaf(-kq, 6.2831854820251465f, ang); rr = fmaf(-kq, -1.7484555314695172e-07f, rr);
      float sn, cs; sn = __sinf(rr); cs = __cosf(rr);
      p.rope[tok * 16 + i] = cs; p.rope[tok * 16 + 8 + i] = sn;
    }
  }
}

__device__ __forceinline__ float softplus_f(float x) { return fmaxf(x, 0.f) + log1pf(__expf(-fabsf(x))); }

__device__ void dn_local_task(const Params& p, int l, int task, unsigned char* smem) {
  const int b = task >> 7, h = (task >> 5) & 3, n = task & 31;
  int tid_ = otid();
  const int tid = tid_, lane = tid & 63, wid = tid >> 6;
  const size_t rowbase = (size_t)b * SEQ + n * 64;
  u16* qn_s = (u16*)smem;
  u16* kn_s = qn_s + 64 * 136;
  u16* v_s = kn_s + 64 * 136;
  float* A_f = (float*)(smem + 52224);
  float* A_b = (float*)smem;
  float* sm = (float*)(smem + 68608);
  float* gcs = sm; float* bts = sm + 128;
  __syncthreads();
  {
    const size_t chunk_id = (size_t)b * 32 + n;
    const int ch = tid & 15, r0 = tid >> 4;
#pragma unroll
    for (int part = 0; part < 3; ++part) {
      const int hc = part * 512 + h * 128 + ch * 8;
      const float* cw = p.conv_qkv + (size_t)l * 3 * 1536 + hc;
      u32x4 xm[4], x0[4], xp[4];
#pragma unroll
      for (int k = 0; k < 4; ++k) {
        const int r = k * 16 + r0;
        const u16* pc = p.proj + (rowbase + r) * LDP + C_QDN + hc;
        const u16* pm = (r == 0) ? (n == 0 ? pc : p.halo + ((chunk_id - 1) * 2 + 1) * 1536 + hc) : pc - LDP;
        const u16* pp = (r == 63) ? (n == 31 ? pc : p.halo + ((chunk_id + 1) * 2 + 0) * 1536 + hc) : pc + LDP;
        xm[k] = ldu4(pm); x0[k] = ldu4(pc); xp[k] = ldu4(pp);
      }
      float w0[8], w1[8], w2[8];
#pragma unroll
      for (int e4 = 0; e4 < 2; ++e4) {
        const f32x4 a0 = *reinterpret_cast<const f32x4*>(cw + e4 * 4), a1 = *reinterpret_cast<const f32x4*>(cw + 1536 + e4 * 4), a2 = *reinterpret_cast<const f32x4*>(cw + 3072 + e4 * 4);
#pragma unroll
        for (int e = 0; e < 4; ++e) { w0[e4 * 4 + e] = a0[e]; w1[e4 * 4 + e] = a1[e]; w2[e4 * 4 + e] = a2[e]; }
      }
      u16* dbase = (part == 0 ? qn_s : (part == 1 ? kn_s : v_s)) + ch * 8;
#pragma unroll
      for (int k = 0; k < 4; ++k) {
        const int r = k * 16 + r0;
        const float mz = (r == 0 && n == 0) ? 0.f : 1.f, pz = (r == 63 && n == 31) ? 0.f : 1.f;
        float fm[8], f0[8], fp[8], o[8];
        unpack8(xm[k], fm); unpack8(x0[k], f0); unpack8(xp[k], fp);
        float ss = 0.f;
#pragma unroll
        for (int e = 0; e < 8; ++e) {
          float a = w1[e] * f0[e] + mz * (w0[e] * fm[e]) + pz * (w2[e] * fp[e]);
          a = silu_f(a);
          o[e] = a; ss += a * a;
        }
        ss += __shfl_xor(ss, 1); ss += __shfl_xor(ss, 2); ss += __shfl_xor(ss, 4); ss += __shfl_xor(ss, 8);
        float sc = 1.f;
        if (part == 0) sc = rsqrtf(ss + EPS) * 0.08838834764831845f;
        else if (part == 1) sc = rsqrtf(ss + EPS);
#pragma unroll
        for (int e = 0; e < 8; ++e) o[e] *= sc;
        *reinterpret_cast<u32x4*>(dbase + r * 136) = pack8(o);
      }
    }
  }
  if (wid < 2) {
    const int dir = wid;
    const int c = dir ? 63 - lane : lane;
    const u16* rp = p.proj + (rowbase + c) * LDP;
    const float a = bf2f(rp[(dir ? C_AB : C_AF) + h]);
    const float bl = bf2f(rp[(dir ? C_BB : C_BF) + h]);
    const float alog = dir ? p.a_log_b[l * 4 + h] : p.a_log_f[l * 4 + h];
    const float dtb = dir ? p.dt_bias_b[l * 4 + h] : p.dt_bias_f[l * 4 + h];
    float g = -__expf(alog) * softplus_f(a + dtb);
    const float beta = 1.f / (1.f + __expf(-bl));
#pragma unroll
    for (int o = 1; o < 64; o <<= 1) { const float t = __shfl_up(g, o); if (lane >= o) g += t; }
    gcs[dir * 64 + lane] = g; bts[dir * 64 + lane] = beta; sm[256 + dir * 64 + lane] = beta * __expf(g);
    const float glast = __shfl(g, 63);
    float* ge = p.gexp + ((((size_t)b * 4 + h) * 2 + dir) * 32 + n) * 192;
    ge[lane] = __expf(g); ge[64 + lane] = __expf(glast - g);
    if (lane == 0) ge[128] = __expf(glast);
  }
  __syncthreads();
  {
#pragma unroll
    for (int it = 0; it < 4; ++it) {
      const int q = tid + 256 * it, r = q >> 4, ch = q & 15;
      *reinterpret_cast<u32x4*>(p.proj + (rowbase + r) * LDP + C_QDN + h * 128 + ch * 8) = *reinterpret_cast<const u32x4*>(qn_s + r * 136 + ch * 8);
    }
#pragma unroll
    for (int it = 0; it < 4; ++it) {
      const int q = tid + 256 * it, kk = q >> 3, c0 = (q & 7) * 8;
      float f[8];
#pragma unroll
      for (int e = 0; e < 8; ++e) f[e] = bf2f(kn_s[(c0 + e) * 136 + kk]);
      *reinterpret_cast<u32x4*>(p.proj + (rowbase + (kk >> 1)) * LDP + C_KDN + h * 128 + (kk & 1) * 64 + c0) = pack8(f);
    }
  }
  const int fr = lane & 15, fq = lane >> 4;
  f32x4 kk[4], qk[4];
#pragma unroll
  for (int jt = 0; jt < 4; ++jt) { kk[jt] = (f32x4){0.f, 0.f, 0.f, 0.f}; qk[jt] = (f32x4){0.f, 0.f, 0.f, 0.f}; }
#pragma unroll
  for (int ks = 0; ks < 4; ++ks) {
    const bf16x8 bk = ld8(kn_s + (16 * wid + fr) * 136 + ks * 32 + fq * 8);
    const bf16x8 bq = ld8(qn_s + (16 * wid + fr) * 136 + ks * 32 + fq * 8);
#pragma unroll
    for (int jt = 0; jt < 4; ++jt) {
      const bf16x8 a = ld8(kn_s + (16 * jt + fr) * 136 + ks * 32 + fq * 8);
      kk[jt] = mfma16(a, bk, kk[jt]);
      qk[jt] = mfma16(a, bq, qk[jt]);
    }
  }
  __syncthreads();
  u16* blk = p.inter + (size_t)task * 32768;
  {
    const int i = 16 * wid + fr, ib = 63 - i;
    const float gfi = gcs[i], gbi = gcs[64 + ib], bfi = bts[i], bbi = bts[64 + ib];
#pragma unroll
    for (int jt = 0; jt < 4; ++jt) {
      const int j0 = 16 * jt + fq * 4;
      f32x4 af, ab, qf, qb;
#pragma unroll
      for (int e = 0; e < 4; ++e) {
        const int j = j0 + e, jb = 63 - j;
        const float df = (i >= j) ? __expf(gfi - gcs[j]) : 0.f;
        const float db = (ib >= jb) ? __expf(gbi - gcs[64 + jb]) : 0.f;
        af[e] = (i > j) ? bfi * kk[jt][e] * df : 0.f;
        qf[e] = qk[jt][e] * df;
        ab[3 - e] = (ib > jb) ? bbi * kk[jt][e] * db : 0.f;
        qb[3 - e] = qk[jt][e] * db;
      }
      *reinterpret_cast<f32x4*>(A_f + i * 64 + j0) = af;
      *reinterpret_cast<f32x4*>(A_b + ib * 64 + (60 - j0)) = ab;
      u32x2 w; w.x = pk_bf16(qf[0], qf[1]); w.y = pk_bf16(qf[2], qf[3]);
      *reinterpret_cast<u32x2*>(blk + 24576 + i * 64 + j0) = w;
      w.x = pk_bf16(qb[0], qb[1]); w.y = pk_bf16(qb[2], qb[3]);
      *reinterpret_cast<u32x2*>(blk + 28672 + ib * 64 + (60 - j0)) = w;
    }
  }
  __syncthreads();
#ifndef NOSOLVE
  {
    const int col = tid & 127; const bool isW = tid >= 128;
    const u16* src = (isW ? kn_s : v_s) + col;
    const float* scb = isW ? (sm + 256) : bts;
#pragma unroll 1
    for (int dir = 0; dir < 2; ++dir) {
      int dsel = dir; asm volatile("" : "+v"(dsel));
      const float* Am = (const float*)(smem + (dsel ? 0 : 52224));
      const float* scp = scb + dsel * 64;
      const u16* sp = src + (dsel ? 63 * 136 : 0);
      const int sstride = dsel ? -136 : 136;
      u16* dstW = blk + (dsel ? 16384 : 0) + col;
      u16* dstU = dsel ? (blk + 8192 + col) : (p.proj + rowbase * LDP + C_VDN + h * 128 + col);
      u16* dst = isW ? dstW : dstU;
      const int ld = (isW || dsel) ? 128 : LDP;
      float x[64];
      const float* Al = Am + (tid & 63);
      float arow_n = Al[64];
#pragma unroll
      for (int i = 0; i < 64; ++i) {
        float a0 = scp[i] * bf2f(*sp), a1 = 0.f, a2 = 0.f, a3 = 0.f;
        sp += sstride;
        const int arow = __float_as_int(arow_n);
        if (i + 1 < 64 && i >= 1) arow_n = Al[(i + 1) * 64];
#pragma unroll
        for (int j = 0; j < i; ++j) {
          int stmp;
          if ((j & 3) == 0) asm volatile("v_readlane_b32 %1, %2, %3\n\tv_fma_f32 %0, -%1, %4, %0" : "+v"(a0), "=&s"(stmp) : "v"(arow), "n"(j), "v"(x[j]));
          else if ((j & 3) == 1) asm volatile("v_readlane_b32 %1, %2, %3\n\tv_fma_f32 %0, -%1, %4, %0" : "+v"(a1), "=&s"(stmp) : "v"(arow), "n"(j), "v"(x[j]));
          else if ((j & 3) == 2) asm volatile("v_readlane_b32 %1, %2, %3\n\tv_fma_f32 %0, -%1, %4, %0" : "+v"(a2), "=&s"(stmp) : "v"(arow), "n"(j), "v"(x[j]));
          else asm volatile("v_readlane_b32 %1, %2, %3\n\tv_fma_f32 %0, -%1, %4, %0" : "+v"(a3), "=&s"(stmp) : "v"(arow), "n"(j), "v"(x[j]));
        }
        x[i] = (a0 + a1) + (a2 + a3);
      }
#pragma unroll
      for (int i = 0; i < 64; ++i) { *dst = f2bf(x[i]); dst += ld; }
    }
  }
#endif
}

struct ScanA { bf16x8 w[4]; u16 u[2][4]; float egl[4]; };
struct ScanB { bf16x8 qn[4], qk[2], kt[2][2]; float eg, gl; };

__device__ __forceinline__ void scan_loadA(const Params& p, int b, int h, int dir, int slice, int s, int wid, int lane, ScanA& L) {
  const int n = dir ? 31 - s : s;
  const int fr = lane & 15, fq = lane >> 4;
  const size_t rowbase = (size_t)b * SEQ + n * 64;
  const u16* blk = p.inter + ((size_t)(b * 4 + h) * 32 + n) * 32768;
  const int cp = 16 * wid + fr;
  const u16* Wp = blk + (dir ? 16384 : 0) + cp * 128 + fq * 8;
#pragma unroll
  for (int ks = 0; ks < 4; ++ks) L.w[ks] = ld8(Wp + ks * 32);
  const float* ge = p.gexp + ((((size_t)b * 4 + h) * 2 + dir) * 32 + n) * 192;
#pragma unroll
  for (int j = 0; j < 4; ++j) L.egl[j] = ge[64 + 16 * wid + fq * 4 + j];
#pragma unroll
  for (int nt = 0; nt < 2; ++nt)
#pragma unroll
    for (int j = 0; j < 4; ++j) {
      const int c2 = 16 * wid + fq * 4 + j, col = slice * 32 + nt * 16 + fr;
      L.u[nt][j] = dir ? blk[8192 + c2 * 128 + col] : p.proj[(rowbase + c2) * LDP + C_VDN + h * 128 + col];
    }
}
__device__ __forceinline__ void scan_loadB(const Params& p, int b, int h, int dir, int s, int wid, int lane, ScanB& L) {
  const int n = dir ? 31 - s : s;
  const int fr = lane & 15, fq = lane >> 4;
  const size_t rowbase = (size_t)b * SEQ + n * 64;
  const u16* blk = p.inter + ((size_t)(b * 4 + h) * 32 + n) * 32768;
  const int cp = 16 * wid + fr;
  const int corig = dir ? 63 - cp : cp;
  const u16* Qp = p.proj + (rowbase + corig) * LDP + C_QDN + h * 128 + fq * 8;
  const u16* QKp = blk + (dir ? 28672 : 24576) + cp * 64 + fq * 8;
#pragma unroll
  for (int ks = 0; ks < 4; ++ks) L.qn[ks] = ld8(Qp + ks * 32);
#pragma unroll
  for (int ks = 0; ks < 2; ++ks) L.qk[ks] = ld8(QKp + ks * 32);
#pragma unroll
  for (int t = 0; t < 2; ++t) {
    const int kk = (2 * wid + t) * 16 + fr;
    const u16* Kp = p.proj + (rowbase + (kk >> 1)) * LDP + C_KDN + h * 128 + (kk & 1) * 64 + fq * 8;
#pragma unroll
    for (int ks = 0; ks < 2; ++ks) L.kt[t][ks] = ld8(Kp + ks * 32);
  }
  const float* ge = p.gexp + ((((size_t)b * 4 + h) * 2 + dir) * 32 + n) * 192;
  L.eg = ge[cp];
  L.gl = ge[128];
}

__device__ __forceinline__ void scan_step(const Params& p, int b, int h, int dir, int slice, int s, int wid, int lane,
                                          u16* ST0, u16* vnT, u16* vnsT, f32x4 (&S)[2][2],
                                          const ScanA& cur, const ScanB& cb, ScanA& nxt, ScanB& cbn) {
  const int fr = lane & 15, fq = lane >> 4;
  if (s + 1 < 32) { scan_loadA(p, b, h, dir, slice, s + 1, wid, lane, nxt); scan_loadB(p, b, h, dir, s + 1, wid, lane, cbn); }
  const u16* STc = ST0 + (s & 1) * 32 * 136;
  u16* STn = ST0 + ((s + 1) & 1) * 32 * 136;
  const int n = dir ? 31 - s : s;
  const size_t rowbase = (size_t)b * SEQ + n * 64;
  f32x4 vn[2];
#pragma unroll
  for (int nt = 0; nt < 2; ++nt) {
    f32x4 acc = (f32x4){0.f, 0.f, 0.f, 0.f};
#pragma unroll
    for (int ks = 0; ks < 4; ++ks) acc = mfma16(cur.w[ks], ld8(STc + (nt * 16 + fr) * 136 + ks * 32 + fq * 8), acc);
#pragma unroll
    for (int j = 0; j < 4; ++j) vn[nt][j] = bf2f(cur.u[nt][j]) - acc[j];
  }
#pragma unroll
  for (int nt = 0; nt < 2; ++nt) {
    const int nn = nt * 16 + fr, c0 = 16 * wid + fq * 4;
    u32x2 w; w.x = pk_bf16(vn[nt][0], vn[nt][1]); w.y = pk_bf16(vn[nt][2], vn[nt][3]);
    *reinterpret_cast<u32x2*>(vnT + nn * 72 + c0) = w;
    const float s0 = vn[nt][0] * cur.egl[0], s1 = vn[nt][1] * cur.egl[1], s2 = vn[nt][2] * cur.egl[2], s3 = vn[nt][3] * cur.egl[3];
    if (dir) { w.x = pk_bf16(s3, s2); w.y = pk_bf16(s1, s0); *reinterpret_cast<u32x2*>(vnsT + nn * 72 + (60 - c0)) = w; }
    else { w.x = pk_bf16(s0, s1); w.y = pk_bf16(s2, s3); *reinterpret_cast<u32x2*>(vnsT + nn * 72 + c0) = w; }
  }
  __syncthreads();
#pragma unroll
  for (int nt = 0; nt < 2; ++nt) {
    f32x4 a1 = (f32x4){0.f, 0.f, 0.f, 0.f}, a2 = (f32x4){0.f, 0.f, 0.f, 0.f};
#pragma unroll
    for (int ks = 0; ks < 4; ++ks) a1 = mfma16(ld8(STc + (nt * 16 + fr) * 136 + ks * 32 + fq * 8), cb.qn[ks], a1);
#pragma unroll
    for (int ks = 0; ks < 2; ++ks) a2 = mfma16(ld8(vnT + (nt * 16 + fr) * 72 + ks * 32 + fq * 8), cb.qk[ks], a2);
    const int cp = 16 * wid + fr, col = slice * 32 + nt * 16 + fq * 4;
    u32x2 w; w.x = pk_bf16(a1[0] * cb.eg + a2[0], a1[1] * cb.eg + a2[1]); w.y = pk_bf16(a1[2] * cb.eg + a2[2], a1[3] * cb.eg + a2[3]);
    u16* op = dir ? (p.inter + ((size_t)(b * 4 + h) * 32 + n) * 32768 + 8192 + cp * 128 + col)
                  : (p.proj + (rowbase + cp) * LDP + C_VDN + h * 128 + col);
    *reinterpret_cast<u32x2*>(op) = w;
  }
#pragma unroll
  for (int t = 0; t < 2; ++t)
#pragma unroll
    for (int nt = 0; nt < 2; ++nt) {
      f32x4 acc = S[t][nt] * cb.gl;
#pragma unroll
      for (int ks = 0; ks < 2; ++ks) acc = mfma16(cb.kt[t][ks], ld8(vnsT + (nt * 16 + fr) * 72 + ks * 32 + fq * 8), acc);
      S[t][nt] = acc;
      u32x2 w; w.x = pk_bf16(acc[0], acc[1]); w.y = pk_bf16(acc[2], acc[3]);
      *reinterpret_cast<u32x2*>(STn + (nt * 16 + fr) * 136 + (2 * wid + t) * 16 + fq * 4) = w;
    }
  __syncthreads();
}

__device__ void scan_task(const Params& p, int sid, unsigned char* smem) {
  const int b = sid >> 5, h = (sid >> 3) & 3, dir = (sid >> 2) & 1, slice = sid & 3;
  int tid_ = otid();
  const int tid = tid_, lane = tid & 63, wid = tid >> 6;
  u16* ST0 = (u16*)smem;
  u16* vnT = ST0 + 2 * 32 * 136;
  u16* vnsT = vnT + 32 * 72;
  __syncthreads();
  for (int i = tid; i < 32 * 136 / 2; i += NT) reinterpret_cast<unsigned*>(ST0)[i] = 0u;
  f32x4 S[2][2];
#pragma unroll
  for (int a = 0; a < 2; ++a)
#pragma unroll
    for (int c = 0; c < 2; ++c) S[a][c] = (f32x4){0.f, 0.f, 0.f, 0.f};
  ScanA a0, a1;
  ScanB b0, b1;
  scan_loadA(p, b, h, dir, slice, 0, wid, lane, a0);
  scan_loadB(p, b, h, dir, 0, wid, lane, b0);
  __syncthreads();
  __builtin_amdgcn_s_setprio(3);
#pragma unroll 1
  for (int s = 0; s < 32; s += 2) {
    scan_step(p, b, h, dir, slice, s, wid, lane, ST0, vnT, vnsT, S, a0, b0, a1, b1);
    scan_step(p, b, h, dir, slice, s + 1, wid, lane, ST0, vnT, vnsT, S, a1, b1, a0, b0);
  }
  __builtin_amdgcn_s_setprio(0);
}

__device__ void attn_task(const Params& p, int aid, int half, unsigned char* smem) {
  const int b = aid / 384, rem = aid % 384, pt = rem >> 7, rem2 = rem & 127, h = rem2 >> 5, q = rem2 & 31;
  const int dl = pt == 0 ? 1 : (pt == 1 ? 4 : 16);
  const int L = SEQ / dl, nbl = L / 64;
  const int r = q / nbl, nb = q % nbl;
  int tid_ = otid();
  const int tid = tid_, lane = tid & 63, wid = tid >> 6, fr = lane & 15, fq = lane >> 4;
  u16* Qs = (u16*)smem;
  u16* Ks = Qs + 64 * 72;
  u16* VT = Ks + 192 * 72;
  u16* Ps = Ks;
  const size_t tokbase = (size_t)b * SEQ;
  const int cq = C_QC + pt * 256 + h * 64, ck = C_KC + pt * 256 + h * 64, cv = C_VC + pt * 256 + h * 64;
  __syncthreads();
  {
    const int ch = tid & 7, rb = tid >> 3;
    u32x4 qk[8], vv[6];
#pragma unroll
    for (int k = 0; k < 8; ++k) {
      const int row = rb + 32 * k;
      const int i = (k < 2) ? nb * 64 + row : nb * 64 - 128 + row;
      qk[k] = (u32x4){0u, 0u, 0u, 0u};
      if (i >= 0 && i < L) qk[k] = ldu4(p.proj + (tokbase + (size_t)i * dl + r) * LDP + ((k < 2) ? cq : ck) + ch * 8);
    }
#pragma unroll
    for (int k = 0; k < 6; ++k) {
      const int j = nb * 64 - 64 + rb + 32 * k;
      vv[k] = (u32x4){0u, 0u, 0u, 0u};
      if (j >= 0 && j < L) vv[k] = ldu4(p.proj + (tokbase + (size_t)j * dl + r) * LDP + cv + ch * 8);
    }
#pragma unroll
    for (int k = 0; k < 8; ++k) {
      const int row = rb + 32 * k;
      u16* dst = ((k < 2) ? Qs + row * 72 : Ks + (row - 64) * 72) + ch * 8;
      *reinterpret_cast<u32x4*>(dst) = qk[k];
    }
#pragma unroll
    for (int k = 0; k < 6; ++k) {
      const u32x4 w = vv[k];
      u16* d = VT + (ch * 8) * 200 + rb + 32 * k;
      d[0] = (u16)(w.x & 0xffff); d[200] = (u16)(w.x >> 16); d[400] = (u16)(w.y & 0xffff); d[600] = (u16)(w.y >> 16);
      d[800] = (u16)(w.z & 0xffff); d[1000] = (u16)(w.z >> 16); d[1200] = (u16)(w.w & 0xffff); d[1400] = (u16)(w.w >> 16);
    }
  }
  __syncthreads();
  {
    const int e = tid & 7, rb = tid >> 3;
#pragma unroll
    for (int k = 0; k < 8; ++k) {
      const int row = rb + 32 * k;
      const int i = (k < 2) ? nb * 64 + row : nb * 64 - 128 + row;
      if (i >= 0 && i < L) {
        const size_t tok = tokbase + (size_t)i * dl + r;
        const float* rp = p.rope + (tok + (size_t)half * 8192) * 16;
        const float cs = rp[e], sn = rp[8 + e];
        u16* buf = (k < 2) ? Qs + row * 72 : Ks + (row - 64) * 72;
        const float x1 = bf2f(buf[e]), x2 = bf2f(buf[8 + e]);
        buf[e] = f2bf(x1 * cs - x2 * sn); buf[8 + e] = f2bf(x2 * cs + x1 * sn);
      }
    }
  }
  __syncthreads();
  f32x4 sc[12];
  {
    const bf16x8 q0 = ld8(Qs + (16 * wid + fr) * 72 + fq * 8), q1 = ld8(Qs + (16 * wid + fr) * 72 + 32 + fq * 8);
#pragma unroll
    for (int kt = 0; kt < 12; ++kt) {
      f32x4 a = (f32x4){0.f, 0.f, 0.f, 0.f};
      a = mfma16(ld8(Ks + (kt * 16 + fr) * 72 + fq * 8), q0, a);
      a = mfma16(ld8(Ks + (kt * 16 + fr) * 72 + 32 + fq * 8), q1, a);
      sc[kt] = a;
    }
  }
  const int qi = nb * 64 + 16 * wid + fr;
  float mx = -3.0e38f;
#pragma unroll
  for (int kt = 0; kt < 12; ++kt)
#pragma unroll
    for (int e = 0; e < 4; ++e) {
      const int j = nb * 64 - 64 + kt * 16 + fq * 4 + e;
      const int d = qi - j;
      const bool valid = (j >= 0) && (j < L) && (d <= 64) && (d >= -64);
      const float s = valid ? sc[kt][e] * 0.125f : -1e30f;
      sc[kt][e] = s; mx = fmaxf(mx, s);
    }
  mx = fmaxf(mx, __shfl_xor(mx, 16)); mx = fmaxf(mx, __shfl_xor(mx, 32));
  float den = 0.f;
#pragma unroll
  for (int kt = 0; kt < 12; ++kt)
#pragma unroll
    for (int e = 0; e < 4; ++e) { const float pe = __expf(sc[kt][e] - mx); sc[kt][e] = pe; den += pe; }
  den += __shfl_xor(den, 16); den += __shfl_xor(den, 32);
  __syncthreads();
#pragma unroll
  for (int kt = 0; kt < 12; ++kt) {
    u32x2 w; w.x = pk_bf16(sc[kt][0], sc[kt][1]); w.y = pk_bf16(sc[kt][2], sc[kt][3]);
    *reinterpret_cast<u32x2*>(Ps + (16 * wid + fr) * 200 + kt * 16 + fq * 4) = w;
  }
  __syncthreads();
  const float inv = 1.f / den;
  const size_t tokq = tokbase + (size_t)qi * dl + r;
#pragma unroll
  for (int dt = 0; dt < 4; ++dt) {
    f32x4 a = (f32x4){0.f, 0.f, 0.f, 0.f};
#pragma unroll
    for (int ks = 0; ks < 6; ++ks) a = mfma16(ld8(VT + (dt * 16 + fr) * 200 + ks * 32 + fq * 8), ld8(Ps + (16 * wid + fr) * 200 + ks * 32 + fq * 8), a);
    u32x2 w; w.x = pk_bf16(a[0] * inv, a[1] * inv); w.y = pk_bf16(a[2] * inv, a[3] * inv);
    *reinterpret_cast<u32x2*>(p.proj + tokq * LDP + cq + dt * 16 + fq * 4) = w;
  }
  if (fq == 0) p.lse[((size_t)pt * 8192 + tokq) * 4 + h] = mx + __logf(den);
}

__device__ void phase_scan_attn(const Params& p, int l, int half, unsigned char* smem) {
  const int bi = obid(), G = gridDim.x;
  const int nscan_blocks = G >= 256 ? 128 : G / 2;
  if (bi < nscan_blocks) {
    for (int t = bi; t < 128; t += nscan_blocks) {
      const int sid = (t & 7) * 16 + (t >> 3);
      scan_task(p, sid, smem);
    }
  } else {
    const int na = G - nscan_blocks;
    for (int t = bi - nscan_blocks; t < 1536; t += na) attn_task(p, t, half, smem);
    if (half == 0) {
      const float* xsrc = (l == 0) ? p.x : p.xres;
      u16* h1 = p.proj + (size_t)8192 * LDP;
      for (int t = bi - nscan_blocks; t < 8192 / 16; t += na) norm_task(xsrc + (size_t)8192 * DM, p.norm_mix + l * DM, h1, nullptr, t);
    } else {
      for (int t = bi - nscan_blocks; t < (DM / 64) * (2 * DFF / 64); t += na)
        wconv_task(p.w_up + (size_t)l * DM * 2 * DFF, DM, 2 * DFF, 2 * DFF, p.WA, t, smem, true);
    }
  }
}

__device__ void combine_task(const Params& p, int l, int task) {
  const int lane = otid() & 63, wid = otid() >> 6;
  const int g16 = lane >> 4;
  u32x2 oa[4], oc[4]; u32x4 ob4[4];
#pragma unroll
  for (int rr = 0; rr < 4; ++rr) {
    const size_t row = (size_t)task * 16 + wid * 4 + rr;
    const int t = (int)(row & (SEQ - 1));
    const u16* rp = p.proj + row * LDP;
    float ya[4];
    {
      const int c = 4 * lane;
      const float* cw = p.conv_a + (size_t)l * 3 * 256 + c;
      float z[4] = {0.f, 0.f, 0.f, 0.f};
#pragma unroll
      for (int i = 0; i < 3; ++i) {
        const int tt = t + i - 1;
        if (tt < 0 || tt >= SEQ) continue;
        const u16* r2 = rp + (ptrdiff_t)(i - 1) * LDP;
        const u32x2 xa = *reinterpret_cast<const u32x2*>(r2 + c), gc = *reinterpret_cast<const u32x2*>(r2 + 512 + c);
        const f32x4 w = *reinterpret_cast<const f32x4*>(cw + i * 256);
        z[0] += w[0] * bflo(xa.x) * bflo(gc.x); z[1] += w[1] * bfhi(xa.x) * bfhi(gc.x);
        z[2] += w[2] * bflo(xa.y) * bflo(gc.y); z[3] += w[3] * bfhi(xa.y) * bfhi(gc.y);
      }
      const u32x2 gb = *reinterpret_cast<const u32x2*>(rp + 256 + c);
      z[0] *= bflo(gb.x); z[1] *= bfhi(gb.x); z[2] *= bflo(gb.y); z[3] *= bfhi(gb.y);
      float ss = z[0] * z[0] + z[1] * z[1] + z[2] * z[2] + z[3] * z[3];
#pragma unroll
      for (int o = 1; o < 16; o <<= 1) ss += __shfl_xor(ss, o);
      const float rs = rsqrtf(ss * (1.f / 64.f) + EPS);
      const f32x4 g = *reinterpret_cast<const f32x4*>(p.norm_a + l * 256 + c);
#pragma unroll
      for (int e = 0; e < 4; ++e) ya[e] = z[e] * rs * g[e];
    }
    float yb[8];
    {
      const int c = 8 * lane, hh = g16, cc = c & 127;
      const int n = t >> 6, ci = t & 63;
      float of[8], ob[8], gt[8];
      unpack8(ldu4(rp + C_VDN + c), of);
      const u16* blk = p.inter + ((size_t)((row >> 11) * 4 + hh) * 32 + n) * 32768;
      unpack8(ldu4(blk + 8192 + (63 - ci) * 128 + cc), ob);
      unpack8(ldu4(rp + C_GATE + c), gt);
      float ss = 0.f;
#pragma unroll
      for (int e = 0; e < 8; ++e) { of[e] += ob[e]; ss += of[e] * of[e]; }
#pragma unroll
      for (int o = 1; o < 16; o <<= 1) ss += __shfl_xor(ss, o);
      const float rs = rsqrtf(ss * (1.f / 128.f) + EPS);
      const float* g = p.norm_dn + l * 128 + cc;
#pragma unroll
      for (int e = 0; e < 8; ++e) yb[e] = of[e] * rs * g[e] * silu_f(gt[e]);
    }
    float yc[4];
    {
      const int c = 4 * lane, hh = g16;
      const float l0 = p.lse[((size_t)0 * 8192 + row) * 4 + hh], l1 = p.lse[((size_t)1 * 8192 + row) * 4 + hh], l2 = p.lse[((size_t)2 * 8192 + row) * 4 + hh];
      const float mxl = fmaxf(l0, fmaxf(l1, l2));
      float a0 = __expf(l0 - mxl), a1 = __expf(l1 - mxl), a2 = __expf(l2 - mxl);
      const float is = 1.f / (a0 + a1 + a2); a0 *= is; a1 *= is; a2 *= is;
      const u32x2 o0 = *reinterpret_cast<const u32x2*>(rp + C_QC + c), o1 = *reinterpret_cast<const u32x2*>(rp + C_QC + 256 + c), o2 = *reinterpret_cast<const u32x2*>(rp + C_QC + 512 + c);
      float o[4];
      o[0] = a0 * bflo(o0.x) + a1 * bflo(o1.x) + a2 * bflo(o2.x); o[1] = a0 * bfhi(o0.x) + a1 * bfhi(o1.x) + a2 * bfhi(o2.x);
      o[2] = a0 * bflo(o0.y) + a1 * bflo(o1.y) + a2 * bflo(o2.y); o[3] = a0 * bfhi(o0.y) + a1 * bfhi(o1.y) + a2 * bfhi(o2.y);
      float ss = o[0] * o[0] + o[1] * o[1] + o[2] * o[2] + o[3] * o[3];
#pragma unroll
      for (int of = 1; of < 16; of <<= 1) ss += __shfl_xor(ss, of);
      const float rs = rsqrtf(ss * (1.f / 64.f) + EPS);
      const f32x4 g = *reinterpret_cast<const f32x4*>(p.norm_c + l * 256 + c);
#pragma unroll
      for (int e = 0; e < 4; ++e) yc[e] = o[e] * rs * g[e];
    }
    oa[rr].x = pk_bf16(ya[0], ya[1]); oa[rr].y = pk_bf16(ya[2], ya[3]);
    ob4[rr] = pack8(yb);
    oc[rr].x = pk_bf16(yc[0], yc[1]); oc[rr].y = pk_bf16(yc[2], yc[3]);
  }
#pragma unroll
  for (int rr = 0; rr < 4; ++rr) {
    u16* yp = p.proj + ((size_t)task * 16 + wid * 4 + rr) * LDP + C_QDN;
    *reinterpret_cast<u32x2*>(yp + 4 * lane) = oa[rr];
    *reinterpret_cast<u32x4*>(yp + 256 + 8 * lane) = ob4[rr];
    *reinterpret_cast<u32x2*>(yp + 768 + 4 * lane) = oc[rr];
  }
}

__device__ void ffn_fix_item(const Params& p, int l, u16* act, int tm, int item) {
  const int cc = item % 352, side = item / 352;
  const int jg = cc * 8, pos = (jg >> 6) * 128 + (jg & 63);
  const int row = tm * 256 + (side ? 255 : 0), tseq = row & (SEQ - 1);
  const u16* ub = p.ubnd + (size_t)tm * 4 * (2 * DFF) + pos;
  const u16* r0; const u16* r1; const u16* r2; bool z0 = false, z2 = false;
  if (side == 0) { r1 = ub; r2 = ub + 2 * DFF; if (tseq == 0) { z0 = true; r0 = ub; } else r0 = ub - (2 * DFF); }
  else { r0 = ub + 2 * (2 * DFF); r1 = ub + 3 * (2 * DFF); if (tseq == SEQ - 1) { z2 = true; r2 = r1; } else r2 = ub + 4 * (2 * DFF); }
  const float* cw = p.conv_ffn + (size_t)l * 3 * 2 * DFF;
  float g[8], v[8];
#pragma unroll
  for (int e = 0; e < 8; ++e) { g[e] = 0.f; v[e] = 0.f; }
#pragma unroll
  for (int i = 0; i < 3; ++i) {
    const u16* rp = i == 0 ? r0 : (i == 1 ? r1 : r2);
    const float mz = ((i == 0 && z0) || (i == 2 && z2)) ? 0.f : 1.f;
    float a[8], bq[8];
    unpack8(ldu4(rp), a); unpack8(ldu4(rp + 64), bq);
    const float* wg = cw + i * 2 * DFF + jg; const float* wv = wg + DFF;
#pragma unroll
    for (int e = 0; e < 8; ++e) { g[e] += mz * (wg[e] * a[e]); v[e] += mz * (wv[e] * bq[e]); }
  }
  float o[8];
#pragma unroll
  for (int e = 0; e < 8; ++e) o[e] = silu_f(g[e]) * v[e];
  *reinterpret_cast<u32x4*>(act + (size_t)row * DFF + jg) = pack8(o);
}

constexpr int STEPS_PER_LAYER = 14;
constexpr int NSTEPS = 2 * STEPS_PER_LAYER + 1;

__device__ void run_step(const Params& p, int step, float* out, unsigned char* smem) {
  if (step == NSTEPS - 1) {
    for (int t = obid(); t < M_TOK / 16; t += gridDim.x) norm_task(p.xres, p.norm_final, nullptr, out, t);
    return;
  }
  const int l = step / STEPS_PER_LAYER, s = step % STEPS_PER_LAYER;
  u16* h = p.inter;
  if (s == 0) {
    phase_norm_w(p, l, 0, 0, true, smem);
  } else if (s < 11) {
    const int half = (s - 1) / 5, q = (s - 1) % 5;
    float* xh = p.xres + (size_t)half * 8192 * DM;
    const float* rin = (l == 0) ? (p.x + (size_t)half * 8192 * DM) : xh;
    const u16* hA = half ? (p.proj + (size_t)8192 * LDP) : h;
    switch (q) {
      case 0: gemm256_phase<EPI_PROJ>(hA, DM, p.WA, 8192, LDP, DM, p.proj, LDP, nullptr, nullptr, p.halo, smem); break;
      case 1: for (int t = obid(); t < 512; t += gridDim.x) dn_local_task(p, l, t, smem); break;
      case 2: phase_scan_attn(p, l, half, smem); break;
      case 3: for (int t = obid(); t < 8192 / 16; t += gridDim.x) combine_task(p, l, t); break;
      default: gemm_phase<EPI_RES>(p.proj + C_QDN, LDP, p.WB, 8192, DM, DM, nullptr, DM, xh, rin, nullptr, smem); break;
    }
  } else if (s == 11) {
    phase_norm_w(p, l, 1, 0, true, smem);
  } else {
    u16* act = p.proj;
    if (s == 12) gemm256_phase<EPI_UPACT>(h, DM, p.WA, M_TOK, 2 * DFF, DM, act, DFF, nullptr, p.conv_ffn + (size_t)l * 3 * 2 * DFF, p.ubnd, smem);
    else {
#pragma unroll 1
      for (int q = obid() >> 3; q < 8 * 8; q += (gridDim.x >> 3)) {
        const int tm = (obid() & 7) * 8 + (q & 7);
#pragma unroll 1
        for (int it = otid(); it < 704; it += NT) ffn_fix_item(p, l, act, tm, it);
      }
      asm volatile("s_waitcnt vmcnt(0)" ::: "memory");
      __syncthreads();
      gemm256_phase<EPI_RES>(act, DFF, p.WB, M_TOK, DM, DFF, nullptr, DM, p.xres, p.xres, nullptr, smem);
    }
  }
}

#define XB_TMO      128
#define XB_XCNT(j)  (256  + 64 * (j))
#define XB_XSUB(j)  (1280 + 64 * (j))
#define XB_XGEN(j)  (2304 + 64 * (j))
#define XB_TOP      3328
#define XB_TOPGEN   3392
#define XCD_BAR_WORDS 3456
#define XB_SPIN_CAP (1u << 18)
#define LAS __attribute__((address_space(3)))

__device__ __forceinline__ unsigned xb_ld(unsigned* p)              { return __hip_atomic_load(p, __ATOMIC_RELAXED, __HIP_MEMORY_SCOPE_AGENT); }
__device__ __forceinline__ unsigned xb_add(unsigned* p, unsigned v) { return __hip_atomic_fetch_add(p, v, __ATOMIC_RELAXED, __HIP_MEMORY_SCOPE_AGENT); }
__device__ __forceinline__ unsigned xb_xcc_id() { return (unsigned)__builtin_amdgcn_s_getreg((3 << 11) | 20) & 0xFu; }
#define XB_SPIN(cond, bar) do { unsigned _sp = 0; while (cond) { __builtin_amdgcn_s_sleep(1); \
    if ((++_sp & 255u) == 0u) { if (xb_ld(&(bar)[XB_TMO])) break; if (_sp > XB_SPIN_CAP) { atomicAdd(&(bar)[XB_TMO], 1u); break; } } } } while (0)

struct XcdBarrier {
    unsigned* bar; unsigned x;
    volatile LAS unsigned* st;
};

__device__ __forceinline__ XcdBarrier xcd_barrier_post(unsigned* bar, volatile LAS unsigned* st) {
    XcdBarrier b; b.bar = bar; b.x = xb_xcc_id(); b.st = st;
    if (threadIdx.x == 0) (void)xb_add(&bar[XB_XCNT(b.x)], 1u);
    return b;
}
__device__ __forceinline__ void xcd_barrier_complete(unsigned* bar, unsigned x, unsigned& nloc, unsigned& nx) {
    const unsigned G = gridDim.x * gridDim.y * gridDim.z;
    unsigned sum, cnt, mine, sp = 0u;
    for (;;) {
        sum = 0u; cnt = 0u; mine = 0u;
#pragma unroll
        for (unsigned j = 0; j < 16; ++j) { const unsigned c = xb_ld(&bar[XB_XCNT(j)]); sum += c; cnt += (c > 0u) ? 1u : 0u; mine = (j == x) ? c : mine; }
        if (sum == G) break;
        __builtin_amdgcn_s_sleep(1);
        if ((++sp & 255u) == 0u) { if (xb_ld(&bar[XB_TMO])) break; if (sp > XB_SPIN_CAP) { atomicAdd(&bar[XB_TMO], 1u); break; } }
    }
    nloc = mine > 0u ? mine : 1u; nx = cnt > 0u ? cnt : 1u;
}

__device__ __forceinline__ void xcd_barrier(const XcdBarrier& b) {
    asm volatile("s_waitcnt vmcnt(0)" ::: "memory");
    __syncthreads();
    if (threadIdx.x == 0) {
        unsigned* bar = b.bar;
        __builtin_amdgcn_s_waitcnt(0);
        unsigned nloc = b.st[0], nx = b.st[1];
        if (nloc == 0u) { xcd_barrier_complete(bar, b.x, nloc, nx); b.st[0] = nloc; b.st[1] = nx; }
        const unsigned old = xb_add(&bar[XB_XSUB(b.x)], 1u);
        const unsigned gen = old / nloc;
        if (old + 1u == (gen + 1u) * nloc) {
            __builtin_amdgcn_fence(__ATOMIC_RELEASE, "agent");
            asm volatile("s_waitcnt vmcnt(0)" ::: "memory");
            const unsigned og = xb_add(&bar[XB_TOP], 1u);
            const unsigned tg = og / nx;
            if (og + 1u == (tg + 1u) * nx) xb_add(&bar[XB_TOPGEN], 1u);
            else XB_SPIN(xb_ld(&bar[XB_TOPGEN]) == tg, bar);
            __builtin_amdgcn_fence(__ATOMIC_ACQUIRE, "agent");
            xb_add(&bar[XB_XGEN(b.x)], 1u);
            asm volatile("s_waitcnt vmcnt(0)" ::: "memory");
        } else {
            XB_SPIN(xb_ld(&bar[XB_XGEN(b.x)]) == gen, bar);
            __builtin_amdgcn_fence(__ATOMIC_ACQUIRE, "agent");
            asm volatile("s_waitcnt vmcnt(0)" ::: "memory");
        }
    }
    __syncthreads();
}


__device__ __forceinline__ void grid_bar(unsigned* ctr, unsigned target) {
  asm volatile("s_waitcnt vmcnt(0)" ::: "memory");
  __syncthreads();
  if (otid() == 0) {
    __builtin_amdgcn_fence(__ATOMIC_RELEASE, "agent");
    asm volatile("s_waitcnt vmcnt(0)" ::: "memory");
    const unsigned grp = obid() & 7u, gsz = gridDim.x >> 3;
    unsigned* cg_ = ctr + 64 * (1 + grp);
    const unsigned old = __hip_atomic_fetch_add(cg_, 1u, __ATOMIC_RELAXED, __HIP_MEMORY_SCOPE_AGENT);
    if (old + 1 == target * gsz) __hip_atomic_fetch_add(ctr, 1u, __ATOMIC_RELAXED, __HIP_MEMORY_SCOPE_AGENT);
    while (__hip_atomic_load(ctr, __ATOMIC_RELAXED, __HIP_MEMORY_SCOPE_AGENT) < target * 8u) { }
    __builtin_amdgcn_fence(__ATOMIC_ACQUIRE, "agent");
  }
  __syncthreads();
}

__global__ void __launch_bounds__(NT, 2) mega_kernel(Params p, int step_lo, int step_hi) {
  extern __shared__ __attribute__((aligned(16))) unsigned char smem[];
  cg::grid_group grid = cg::this_grid();
  __shared__ unsigned xb_words[4];
  if (threadIdx.x == 0) { xb_words[0] = 0u; xb_words[1] = 0u; }
  __syncthreads();
  const XcdBarrier xb = xcd_barrier_post(p.bar, (volatile LAS unsigned*)&xb_words);
  for (int step = step_lo; step < step_hi; ++step) {
    run_step(p, step, (float*)p.out, smem);
    if (step + 1 < step_hi) {
      if (step_hi < 0) grid.sync();
      xcd_barrier(xb);
    }
  }
}

extern "C" void kernel_launch(void* const* d_in, const int* in_sizes, int n_in, void* d_out, int out_size, void* d_ws, size_t ws_size,
                              hipStream_t stream) {
  static int grid_blocks = 0;
  if (!grid_blocks) {
    int dev = 0, cus = 0, per_cu = 0;
    hipGetDevice(&dev);
    hipDeviceGetAttribute(&cus, hipDeviceAttributeMultiprocessorCount, dev);
    hipFuncSetAttribute((const void*)mega_kernel, hipFuncAttributeMaxDynamicSharedMemorySize, SMEM_BYTES);
    hipOccupancyMaxActiveBlocksPerMultiprocessor(&per_cu, mega_kernel, NT, SMEM_BYTES);
    if (per_cu > 2) per_cu = 2;
    if (per_cu < 1) per_cu = 1;
    grid_blocks = cus * per_cu;
    grid_blocks -= grid_blocks % 8;
  }
  Params p{};
  p.x = (const float*)d_in[0]; p.pos = (const int*)d_in[1]; p.norm_mix = (const float*)d_in[2]; p.w_in = (const float*)d_in[3];
  p.conv_a = (const float*)d_in[4]; p.norm_a = (const float*)d_in[5]; p.conv_qkv = (const float*)d_in[6];
  p.a_log_f = (const float*)d_in[7]; p.a_log_b = (const float*)d_in[8]; p.dt_bias_f = (const float*)d_in[9]; p.dt_bias_b = (const float*)d_in[10];
  p.norm_dn = (const float*)d_in[11]; p.norm_c = (const float*)d_in[12]; p.w_o = (const float*)d_in[13]; p.norm_ffn = (const float*)d_in[14];
  p.w_up = (const float*)d_in[15]; p.conv_ffn = (const float*)d_in[16]; p.w_down = (const float*)d_in[17]; p.norm_final = (const float*)d_in[18];
  p.out = (float*)d_out;
  unsigned char* ws = (unsigned char*)d_ws;
  size_t off = 0;
  p.proj = (u16*)(ws + off); off += (size_t)8192 * 3 * DFF * 2;
  p.inter = (u16*)(ws + off); off += (size_t)512 * 65536;
  p.WA = (u16*)(ws + off); off += (size_t)2 * DFF * DM * 2;
  p.WB = (u16*)(ws + off); off += (size_t)DM * DFF * 2;
  p.halo = (u16*)(ws + off); off += (size_t)256 * 1536 * 2;
  p.lse = (float*)(ws + off); off += (size_t)3 * 8192 * 4 * 4;
  p.gexp = (float*)(ws + off); off += (size_t)1024 * 192 * 4;
  p.rope = (float*)(ws + off); off += (size_t)M_TOK * 16 * 4;
  p.xres = (float*)(ws + off); off += (size_t)M_TOK * DM * 4;
  p.bar = (unsigned*)(ws + off); off += 16384;
  p.ubnd = (u16*)(ws + off); off += (size_t)128 * 4 * 2 * DFF * 2;
  if (off > ws_size) { fprintf(stderr, "workspace too small: need %zu have %zu\n", off, ws_size); return; }
#if MEGA
  hipMemsetAsync(p.bar, 0, 16384, stream);
  int lo = 0, hi = NSTEPS;
  void* args[] = {&p, &lo, &hi};
  hipError_t e = hipLaunchCooperativeKernel((const void*)mega_kernel, dim3(grid_blocks), dim3(NT), args, SMEM_BYTES, stream);
  if (e != hipSuccess) fprintf(stderr, "cooperative launch failed: %s (grid %d)\n", hipGetErrorString(e), grid_blocks);
#else
  for (int s = 0; s < NSTEPS; ++s) hipLaunchKernelGGL(mega_kernel, dim3(grid_blocks), dim3(NT), SMEM_BYTES, stream, p, s, s + 1);
#endif
}
```

```cpp
#include <hip/hip_runtime.h>
#include <hip/hip_cooperative_groups.h>
#include <cstdio>
#include <cstdint>
namespace cg = cooperative_groups;

#ifndef MEGA
#define MEGA 1
#endif

typedef unsigned short u16;
typedef short bf16x8 __attribute__((ext_vector_type(8)));
typedef float f32x4 __attribute__((ext_vector_type(4)));
typedef unsigned u32x4 __attribute__((ext_vector_type(4)));
typedef unsigned u32x2 __attribute__((ext_vector_type(2)));

constexpr int NT = 256;
constexpr int M_TOK = 16384, SEQ = 2048, DM = 1024;
constexpr int LDP = 5248;
constexpr int INW = 5136;
constexpr int DFF = 2816;
constexpr int C_QDN = 768, C_KDN = 1280, C_VDN = 1792, C_GATE = 2304, C_BF = 2816, C_BB = 2820, C_AF = 2824, C_AB = 2828;
constexpr int C_QC = 2832, C_KC = 3600, C_VC = 4368;
constexpr float EPS = 1e-6f;
constexpr int SMEM_BYTES = 73728;

struct Params {
  const float* x; const int* pos; const float* norm_mix; const float* w_in; const float* conv_a; const float* norm_a;
  const float* conv_qkv; const float* a_log_f; const float* a_log_b; const float* dt_bias_f; const float* dt_bias_b;
  const float* norm_dn; const float* norm_c; const float* w_o; const float* norm_ffn; const float* w_up; const float* conv_ffn;
  const float* w_down; const float* norm_final;
  float* xres;
  float* out;
  u16* proj;
  u16* inter;
  u16* WA; u16* WB; u16* halo; float* lse; float* gexp; float* rope;
  u16* ubnd;
  unsigned* bar;
};

__device__ __forceinline__ int obid() { int b = __builtin_amdgcn_workgroup_id_x(); asm volatile("" : "+s"(b)); return b; }
__device__ __forceinline__ int otid() { int t = __builtin_amdgcn_workitem_id_x(); asm volatile("" : "+v"(t)); return t; }
typedef float f32x2_t __attribute__((ext_vector_type(2)));
typedef __bf16 bf16x2_t __attribute__((ext_vector_type(2)));
__device__ __forceinline__ unsigned pk_bf16(float lo, float hi) {
  f32x2_t v = {lo, hi};
  bf16x2_t b = __builtin_convertvector(v, bf16x2_t);
  return __builtin_bit_cast(unsigned, b);
}
__device__ __forceinline__ u16 f2bf(float f) { return (u16)(pk_bf16(f, 0.f) & 0xffffu); }
__device__ __forceinline__ float bf2f(u16 h) { return __uint_as_float(((unsigned)h) << 16); }
__device__ __forceinline__ float bflo(unsigned w) { return __uint_as_float(w << 16); }
__device__ __forceinline__ float bfhi(unsigned w) { return __uint_as_float(w & 0xffff0000u); }
__device__ __forceinline__ float silu_f(float x) { return x / (1.f + __expf(-x)); }
__device__ __forceinline__ f32x4 mfma16(bf16x8 a, bf16x8 b, f32x4 c) { return __builtin_amdgcn_mfma_f32_16x16x32_bf16(a, b, c, 0, 0, 0); }
__device__ __forceinline__ bf16x8 ld8(const u16* p) { return *reinterpret_cast<const bf16x8*>(p); }
__device__ __forceinline__ u32x4 ldu4(const u16* p) { return *reinterpret_cast<const u32x4*>(p); }
__device__ __forceinline__ void unpack8(u32x4 w, float* f) {
  f[0] = bflo(w.x); f[1] = bfhi(w.x); f[2] = bflo(w.y); f[3] = bfhi(w.y);
  f[4] = bflo(w.z); f[5] = bfhi(w.z); f[6] = bflo(w.w); f[7] = bfhi(w.w);
}
__device__ __forceinline__ u32x4 pack8(const float* f) {
  u32x4 w; w.x = pk_bf16(f[0], f[1]); w.y = pk_bf16(f[2], f[3]); w.z = pk_bf16(f[4], f[5]); w.w = pk_bf16(f[6], f[7]); return w;
}

constexpr int EPI_PROJ = 0, EPI_RES = 1, EPI_BF16 = 2, EPI_UPACT = 3;
constexpr int GLD = 64;
constexpr int GBUF = 2 * 128 * GLD;

template <int EPI>
__device__ void gemm_phase(const u16* __restrict__ A, int lda, const u16* __restrict__ Bt, int Mrows, int N, int K,
                           u16* Cb, int ldc, float* Cres, const float* Rin, u16* halo, unsigned char* smem) {
  u16* As = (u16*)smem;
  u16* Bs = As + 128 * GLD;
  const int tid = otid(), lane = tid & 63, wid = tid >> 6, wr = wid >> 1, wc = wid & 1;
  const int fr = lane & 15, fq = lane >> 4;
  const int ntm = Mrows / 128, ntn = N / 128, ntiles = ntm * ntn;
  const int nk = K / 64;
  const int xcd = obid() & 7, jb = obid() >> 3, nper = gridDim.x >> 3, tmper = ntm >> 3;
  (void)ntiles;
  for (int q = jb; q < tmper * ntn; q += nper) {
    const int tm = xcd * tmper + (q % tmper), tn = q / tmper;
    const int m0 = tm * 128, n0 = tn * 128;
    f32x4 acc[4][4];
#pragma unroll
    for (int i = 0; i < 4; ++i)
#pragma unroll
      for (int j = 0; j < 4; ++j) acc[i][j] = (f32x4){0.f, 0.f, 0.f, 0.f};
    u32x4 ra0[4], rb0[4], ra1[4], rb1[4];
    const int lrow = tid >> 3, lch = tid & 7;
    const int swc = lch ^ (lrow & 7);
    const u16* Ag = A + (size_t)(m0 + lrow) * lda + lch * 8;
    const u16* Bg = Bt + (size_t)(n0 + lrow) * K + lch * 8;
#define G_LOAD(RA, RB, KT) do { const int ko_ = (KT) * 64; _Pragma("unroll") for (int i = 0; i < 4; ++i) { RA[i] = ldu4(Ag + (size_t)(i * 32) * lda + ko_); RB[i] = ldu4(Bg + (size_t)(i * 32) * K + ko_); } } while (0)
#define G_STORE(RA, RB, ST) do { u16* An_ = As + (ST) * GBUF; u16* Bn_ = Bs + (ST) * GBUF; _Pragma("unroll") for (int i = 0; i < 4; ++i) { \
      *reinterpret_cast<u32x4*>(An_ + (lrow + i * 32) * GLD + swc * 8) = RA[i]; *reinterpret_cast<u32x4*>(Bn_ + (lrow + i * 32) * GLD + swc * 8) = RB[i]; } } while (0)
#define G_COMPUTE(ST) do { const u16* Ac = As + (ST) * GBUF; const u16* Bc = Bs + (ST) * GBUF; _Pragma("unroll") for (int ks = 0; ks < 2; ++ks) { \
      bf16x8 af[4], bfr[4]; _Pragma("unroll") for (int i = 0; i < 4; ++i) { \
        af[i] = ld8(Ac + (wr * 64 + i * 16 + fr) * GLD + (((ks * 4 + fq) ^ (fr & 7)) * 8)); \
        bfr[i] = ld8(Bc + (wc * 64 + i * 16 + fr) * GLD + (((ks * 4 + fq) ^ (fr & 7)) * 8)); } \
      __builtin_amdgcn_s_setprio(1); \
      _Pragma("unroll") for (int mt = 0; mt < 4; ++mt) _Pragma("unroll") for (int nt = 0; nt < 4; ++nt) acc[mt][nt] = mfma16(bfr[nt], af[mt], acc[mt][nt]); \
      __builtin_amdgcn_s_setprio(0); } } while (0)
    G_LOAD(ra0, rb0, 0);
    G_LOAD(ra1, rb1, 1);
    __syncthreads();
    G_STORE(ra0, rb0, 0);
    __syncthreads();
    for (int kt = 0; kt < nk; kt += 2) {
      if (kt + 2 < nk) G_LOAD(ra0, rb0, kt + 2);
      G_COMPUTE(0);
      G_STORE(ra1, rb1, 1);
      __syncthreads();
      if (kt + 3 < nk) G_LOAD(ra1, rb1, kt + 3);
      G_COMPUTE(1);
      if (kt + 2 < nk) G_STORE(ra0, rb0, 0);
      __syncthreads();
    }
#undef G_LOAD
#undef G_STORE
#undef G_COMPUTE
    if (EPI == EPI_UPACT) {
      u16* T = (u16*)smem;
#pragma unroll
      for (int mt = 0; mt < 4; ++mt)
#pragma unroll
        for (int nt = 0; nt < 4; ++nt) {
          const f32x4 v = acc[mt][nt];
          u32x2 w; w.x = pk_bf16(v[0], v[1]); w.y = pk_bf16(v[2], v[3]);
          *reinterpret_cast<u32x2*>(T + (wr * 64 + mt * 16 + fr) * 136 + wc * 64 + nt * 16 + fq * 4) = w;
        }
      __syncthreads();
      const int jc = tid & 7, jg = tn * 64 + jc * 8;
      const float* cw = Rin;
      float wg[3][8], wv[3][8];
#pragma unroll
      for (int i = 0; i < 3; ++i)
#pragma unroll
        for (int e4 = 0; e4 < 2; ++e4) {
          const f32x4 a = *reinterpret_cast<const f32x4*>(cw + i * 2 * DFF + jg + e4 * 4), bq = *reinterpret_cast<const f32x4*>(cw + i * 2 * DFF + DFF + jg + e4 * 4);
#pragma unroll
          for (int e = 0; e < 4; ++e) { wg[i][e4 * 4 + e] = a[e]; wv[i][e4 * 4 + e] = bq[e]; }
        }
#pragma unroll 1
      for (int k = 0; k < 4; ++k) {
        const int t = (tid >> 3) + 32 * k;
        if (t >= 1 && t <= 126) {
          float g[8], vv[8];
#pragma unroll
          for (int e = 0; e < 8; ++e) { g[e] = 0.f; vv[e] = 0.f; }
#pragma unroll
          for (int i = 0; i < 3; ++i) {
            float a[8], bq[8];
            unpack8(*reinterpret_cast<const u32x4*>(T + (t + i - 1) * 136 + jc * 8), a);
            unpack8(*reinterpret_cast<const u32x4*>(T + (t + i - 1) * 136 + 64 + jc * 8), bq);
#pragma unroll
            for (int e = 0; e < 8; ++e) { g[e] += wg[i][e] * a[e]; vv[e] += wv[i][e] * bq[e]; }
          }
          float o[8];
#pragma unroll
          for (int e = 0; e < 8; ++e) o[e] = silu_f(g[e]) * vv[e];
          *reinterpret_cast<u32x4*>(Cb + (size_t)(m0 + t) * ldc + jg) = pack8(o);
        }
        if (t <= 1 || t >= 126) {
          const int slot = (t <= 1) ? t : t - 124;
          u16* ub = halo + (size_t)(tm * 4 + slot) * (2 * DFF) + n0;
          *reinterpret_cast<u32x4*>(ub + jc * 8) = *reinterpret_cast<const u32x4*>(T + t * 136 + jc * 8);
          *reinterpret_cast<u32x4*>(ub + 64 + jc * 8) = *reinterpret_cast<const u32x4*>(T + t * 136 + 64 + jc * 8);
        }
      }
      continue;
    }
    if (EPI == EPI_RES) {
      f32x4 r[4][4];
#pragma unroll
      for (int mt = 0; mt < 4; ++mt)
#pragma unroll
        for (int nt = 0; nt < 4; ++nt) r[mt][nt] = *reinterpret_cast<const f32x4*>(Rin + (size_t)(m0 + wr * 64 + mt * 16 + fr) * ldc + n0 + wc * 64 + nt * 16 + fq * 4);
#pragma unroll
      for (int mt = 0; mt < 4; ++mt)
#pragma unroll
        for (int nt = 0; nt < 4; ++nt) *reinterpret_cast<f32x4*>(Cres + (size_t)(m0 + wr * 64 + mt * 16 + fr) * ldc + n0 + wc * 64 + nt * 16 + fq * 4) = r[mt][nt] + acc[mt][nt];
      continue;
    }
#pragma unroll
    for (int mt = 0; mt < 4; ++mt) {
      const int m = m0 + wr * 64 + mt * 16 + fr;
#pragma unroll
      for (int nt = 0; nt < 4; ++nt) {
        const int n = n0 + wc * 64 + nt * 16 + fq * 4;
        const f32x4 v = acc[mt][nt];
        if (EPI == EPI_RES) {
          float* p = Cres + (size_t)m * ldc + n;
          f32x4 o = *reinterpret_cast<const f32x4*>(Rin + (size_t)m * ldc + n);
          o += v;
          *reinterpret_cast<f32x4*>(p) = o;
        } else {
          u32x2 w; w.x = pk_bf16(v[0], v[1]); w.y = pk_bf16(v[2], v[3]);
          *reinterpret_cast<u32x2*>(Cb + (size_t)m * ldc + n) = w;
          if (EPI == EPI_PROJ) {
            const int mm = m & 63;
            if ((mm == 0 || mm == 63) && n >= C_QDN && n < C_GATE)
              *reinterpret_cast<u32x2*>(halo + (size_t)((m >> 6) * 2 + (mm == 63 ? 1 : 0)) * 1536 + (n - C_QDN)) = w;
          }
        }
      }
    }
  }
}

template <int EPI>
__device__ void gemm256_phase(const u16* __restrict__ A, int lda, const u16* __restrict__ Bt, int Mrows, int N, int K,
                              u16* Cb, int ldc, float* Cres, const float* Rin, u16* halo, unsigned char* smem) {
  u16* As = (u16*)smem;
  u16* Bs = As + 256 * 64;
  const int tid = otid(), lane = tid & 63, wid = tid >> 6, wr = wid >> 1, wc = wid & 1;
  const int fr = lane & 15, fq = lane >> 4;
  const int ntm = Mrows / 256, ntn = N / 128, nk = K / 64;
  const int xcd = obid() & 7, jb = obid() >> 3, nper = gridDim.x >> 3, tmper = ntm >> 3;
  for (int q = jb; q < tmper * ntn; q += nper) {
    const int tm = xcd * tmper + (q % tmper), tn = q / tmper;
    const int m0 = tm * 256, n0 = tn * 128;
    f32x4 acc[8][4];
#pragma unroll
    for (int i = 0; i < 8; ++i)
#pragma unroll
      for (int j = 0; j < 4; ++j) acc[i][j] = (f32x4){0.f, 0.f, 0.f, 0.f};
    u32x4 ra[8], rb[4];
    const int lrow = tid >> 3, lch = tid & 7;
    const int swc = lch ^ (lrow & 7);
    const u16* Ag = A + (size_t)(m0 + lrow) * lda + lch * 8;
    const u16* Bg = Bt + (size_t)(n0 + lrow) * K + lch * 8;
#pragma unroll
    for (int i = 0; i < 8; ++i) ra[i] = ldu4(Ag + (size_t)(i * 32) * lda);
#pragma unroll
    for (int i = 0; i < 4; ++i) rb[i] = ldu4(Bg + (size_t)(i * 32) * K);
    for (int kt = 0; kt < nk; ++kt) {
      __syncthreads();
#pragma unroll
      for (int i = 0; i < 8; ++i) *reinterpret_cast<u32x4*>(As + (lrow + i * 32) * 64 + swc * 8) = ra[i];
#pragma unroll
      for (int i = 0; i < 4; ++i) *reinterpret_cast<u32x4*>(Bs + (lrow + i * 32) * 64 + swc * 8) = rb[i];
      __syncthreads();
      if (kt + 1 < nk) {
        const int ko = (kt + 1) * 64;
#pragma unroll
        for (int i = 0; i < 8; ++i) ra[i] = ldu4(Ag + (size_t)(i * 32) * lda + ko);
#pragma unroll
        for (int i = 0; i < 4; ++i) rb[i] = ldu4(Bg + (size_t)(i * 32) * K + ko);
      }
#pragma unroll
      for (int ks = 0; ks < 2; ++ks) {
        const int sw = ((ks * 4 + fq) ^ (fr & 7)) * 8;
        bf16x8 bfr[4];
#pragma unroll
        for (int i = 0; i < 4; ++i) bfr[i] = ld8(Bs + (wc * 64 + i * 16 + fr) * 64 + sw);
#pragma unroll
        for (int mh = 0; mh < 2; ++mh) {
          bf16x8 af[4];
#pragma unroll
          for (int i = 0; i < 4; ++i) af[i] = ld8(As + (wr * 128 + (mh * 4 + i) * 16 + fr) * 64 + sw);
#pragma unroll
          for (int i = 0; i < 4; ++i)
#pragma unroll
            for (int nt = 0; nt < 4; ++nt) acc[mh * 4 + i][nt] = mfma16(bfr[nt], af[i], acc[mh * 4 + i][nt]);
        }
      }
    }
    if (EPI == EPI_UPACT) {
      u16* T = (u16*)smem;
      __syncthreads();
#pragma unroll
      for (int mt = 0; mt < 8; ++mt)
#pragma unroll
        for (int nt = 0; nt < 4; ++nt) {
          const f32x4 v = acc[mt][nt];
          u32x2 w; w.x = pk_bf16(v[0], v[1]); w.y = pk_bf16(v[2], v[3]);
          *reinterpret_cast<u32x2*>(T + (wr * 128 + mt * 16 + fr) * 136 + wc * 64 + nt * 16 + fq * 4) = w;
        }
      __syncthreads();
      const int jc = tid & 7, jg = tn * 64 + jc * 8;
      const float* cw = Rin;
      float wg[3][8], wv[3][8];
#pragma unroll
      for (int i = 0; i < 3; ++i)
#pragma unroll
        for (int e4 = 0; e4 < 2; ++e4) {
          const f32x4 a = *reinterpret_cast<const f32x4*>(cw + i * 2 * DFF + jg + e4 * 4), bq = *reinterpret_cast<const f32x4*>(cw + i * 2 * DFF + DFF + jg + e4 * 4);
#pragma unroll
          for (int e = 0; e < 4; ++e) { wg[i][e4 * 4 + e] = a[e]; wv[i][e4 * 4 + e] = bq[e]; }
        }
#pragma unroll 1
      for (int k = 0; k < 8; ++k) {
        const int t = (tid >> 3) + 32 * k;
        if (t >= 1 && t <= 254) {
          float g[8], vv[8];
#pragma unroll
          for (int e = 0; e < 8; ++e) { g[e] = 0.f; vv[e] = 0.f; }
#pragma unroll
          for (int i = 0; i < 3; ++i) {
            float a[8], bq[8];
            unpack8(*reinterpret_cast<const u32x4*>(T + (t + i - 1) * 136 + jc * 8), a);
            unpack8(*reinterpret_cast<const u32x4*>(T + (t + i - 1) * 136 + 64 + jc * 8), bq);
#pragma unroll
            for (int e = 0; e < 8; ++e) { g[e] += wg[i][e] * a[e]; vv[e] += wv[i][e] * bq[e]; }
          }
          float o[8];
#pragma unroll
          for (int e = 0; e < 8; ++e) o[e] = silu_f(g[e]) * vv[e];
          *reinterpret_cast<u32x4*>(Cb + (size_t)(m0 + t) * ldc + jg) = pack8(o);
        }
        if (t <= 1 || t >= 254) {
          const int slot = (t <= 1) ? t : t - 252;
          u16* ub = halo + (size_t)(tm * 4 + slot) * (2 * DFF) + n0;
          *reinterpret_cast<u32x4*>(ub + jc * 8) = *reinterpret_cast<const u32x4*>(T + t * 136 + jc * 8);
          *reinterpret_cast<u32x4*>(ub + 64 + jc * 8) = *reinterpret_cast<const u32x4*>(T + t * 136 + 64 + jc * 8);
        }
      }
      continue;
    }
    if (EPI == EPI_RES) {
#pragma unroll
      for (int mh = 0; mh < 2; ++mh) {
        f32x4 r[4][4];
#pragma unroll
        for (int mt = 0; mt < 4; ++mt)
#pragma unroll
          for (int nt = 0; nt < 4; ++nt) r[mt][nt] = *reinterpret_cast<const f32x4*>(Rin + (size_t)(m0 + wr * 128 + (mh * 4 + mt) * 16 + fr) * ldc + n0 + wc * 64 + nt * 16 + fq * 4);
#pragma unroll
        for (int mt = 0; mt < 4; ++mt)
#pragma unroll
          for (int nt = 0; nt < 4; ++nt) *reinterpret_cast<f32x4*>(Cres + (size_t)(m0 + wr * 128 + (mh * 4 + mt) * 16 + fr) * ldc + n0 + wc * 64 + nt * 16 + fq * 4) = r[mt][nt] + acc[mh * 4 + mt][nt];
      }
      continue;
    }
#pragma unroll
    for (int mt = 0; mt < 8; ++mt) {
      const int m = m0 + wr * 128 + mt * 16 + fr;
#pragma unroll
      for (int nt = 0; nt < 4; ++nt) {
        const int n = n0 + wc * 64 + nt * 16 + fq * 4;
        const f32x4 v = acc[mt][nt];
        if (EPI == EPI_RES) {
          float* p = Cres + (size_t)m * ldc + n;
          f32x4 o = *reinterpret_cast<const f32x4*>(Rin + (size_t)m * ldc + n);
          o += v;
          *reinterpret_cast<f32x4*>(p) = o;
        } else {
          u32x2 w; w.x = pk_bf16(v[0], v[1]); w.y = pk_bf16(v[2], v[3]);
          *reinterpret_cast<u32x2*>(Cb + (size_t)m * ldc + n) = w;
          if (EPI == EPI_PROJ) {
            const int mm = m & 63;
            if ((mm == 0 || mm == 63) && n >= C_QDN && n < C_GATE)
              *reinterpret_cast<u32x2*>(halo + (size_t)((m >> 6) * 2 + (mm == 63 ? 1 : 0)) * 1536 + (n - C_QDN)) = w;
          }
        }
      }
    }
  }
}

__device__ void norm_task(const float* src, const float* __restrict__ g, u16* dst, float* dstf, int task) {
  const int lane = otid() & 63, wid = otid() >> 6;
#pragma unroll 1
  for (int rr = 0; rr < 4; ++rr) {
    const int row = task * 16 + wid * 4 + rr;
    const float* s = src + (size_t)row * DM;
    f32x4 v[4]; float ss = 0.f;
#pragma unroll
    for (int i = 0; i < 4; ++i) { v[i] = *reinterpret_cast<const f32x4*>(s + i * 256 + lane * 4); ss += v[i][0] * v[i][0] + v[i][1] * v[i][1] + v[i][2] * v[i][2] + v[i][3] * v[i][3]; }
#pragma unroll
    for (int o = 1; o < 64; o <<= 1) ss += __shfl_xor(ss, o);
    const float rs = rsqrtf(ss * (1.f / DM) + EPS);
#pragma unroll
    for (int i = 0; i < 4; ++i) {
      const f32x4 gg = *reinterpret_cast<const f32x4*>(g + i * 256 + lane * 4);
      f32x4 y; y[0] = v[i][0] * rs * gg[0]; y[1] = v[i][1] * rs * gg[1]; y[2] = v[i][2] * rs * gg[2]; y[3] = v[i][3] * rs * gg[3];
      if (dstf) *reinterpret_cast<f32x4*>(dstf + (size_t)row * DM + i * 256 + lane * 4) = y;
      else { u32x2 w; w.x = pk_bf16(y[0], y[1]); w.y = pk_bf16(y[2], y[3]); *reinterpret_cast<u32x2*>(dst + (size_t)row * DM + i * 256 + lane * 4) = w; }
    }
  }
}

__device__ void wconv_task(const float* __restrict__ W, int K, int N, int Npad, u16* Wt, int task, unsigned char* smem, bool perm = false) {
  float* tl = (float*)smem;
  const int ntn = Npad / 64;
  const int tk = task / ntn, tn = task % ntn;
  const int k0 = tk * 64, n0 = tn * 64, tid = otid();
  __syncthreads();
#pragma unroll
  for (int i = 0; i < 4; ++i) {
    const int k = (tid >> 4) + 16 * i, n4 = (tid & 15) * 4;
    f32x4 v = (f32x4){0.f, 0.f, 0.f, 0.f};
    if (n0 + n4 < N) v = *reinterpret_cast<const f32x4*>(W + (size_t)(k0 + k) * N + n0 + n4);
    tl[k * 65 + n4 + 0] = v[0]; tl[k * 65 + n4 + 1] = v[1]; tl[k * 65 + n4 + 2] = v[2]; tl[k * 65 + n4 + 3] = v[3];
  }
  __syncthreads();
  const int n = tid >> 2, ks = (tid & 3) * 16;
  float f[16];
#pragma unroll
  for (int i = 0; i < 16; ++i) f[i] = tl[(ks + i) * 65 + n];
  const int dn0 = perm ? (n0 < DFF ? (n0 >> 6) * 128 : ((n0 - DFF) >> 6) * 128 + 64) : n0;
  u16* o = Wt + (size_t)(dn0 + n) * K + k0 + ks;
  *reinterpret_cast<u32x4*>(o) = pack8(f);
  *reinterpret_cast<u32x4*>(o + 8) = pack8(f + 8);
}

__device__ void phase_norm_w(const Params& p, int l, int mode, int half, bool with_w, unsigned char* smem) {
  const int n_norm = (mode == 0 ? 8192 : M_TOK) / 16;
  int nA = 0, nB = 0;
  if (with_w) {
    if (mode == 0) { nA = (DM / 64) * (LDP / 64); nB = (DM / 64) * (DM / 64); }
    else { nA = 0; nB = (DFF / 64) * (DM / 64); }
  }
  const int n_rope = (with_w && mode == 0 && l == 0) ? (M_TOK * 8 / NT) : 0;
  const int total = n_norm + nA + nB + n_rope;
  u16* h = p.inter;
  const float* xsrc = (l == 0 && mode == 0) ? p.x : p.xres;
  for (int t = obid(); t < total; t += gridDim.x) {
    if (t < n_norm) {
      if (mode == 0) norm_task(xsrc + (size_t)half * 8192 * DM, p.norm_mix + l * DM, h, nullptr, t);
      else norm_task(p.xres, p.norm_ffn + l * DM, h, nullptr, t);
    } else if (t < n_norm + nA) {
      if (mode == 0) wconv_task(p.w_in + (size_t)l * DM * INW, DM, INW, LDP, p.WA, t - n_norm, smem);
      else wconv_task(p.w_up + (size_t)l * DM * 2 * DFF, DM, 2 * DFF, 2 * DFF, p.WA, t - n_norm, smem, true);
    } else if (t < n_norm + nA + nB) {
      if (mode == 0) wconv_task(p.w_o + (size_t)l * DM * DM, DM, DM, DM, p.WB, t - n_norm - nA, smem);
      else wconv_task(p.w_down + (size_t)l * DFF * DM, DFF, DM, DM, p.WB, t - n_norm - nA, smem);
    } else {
      const int idx = (t - n_norm - nA - nB) * NT + otid();
      const int tok = idx >> 3, i = idx & 7;
      const float invf[8] = {1.0f, 0.1939227432012558f, 0.03760603070259094f, 0.007292664609849453f, 0.0014142135623842478f,
                             0.00027424818836152554f, 5.318296098266728e-05f, 1.0313386155758053e-05f};
      float fr = invf[0];
#pragma unroll
      for (int q = 1; q < 8; ++q) fr = (i == q) ? invf[q] : fr;
      const float ang = (float)p.pos[tok] * fr;
      const float kq = rintf(ang * 0.15915494309189535f);
      float rr = fmaf(-kq, 6.2831854820251465f, ang); rr = fmaf(-kq, -1.7484555314695172e-07f, rr);
      float sn, cs; sn = __sinf(rr); cs = __cosf(rr);
      p.rope[tok * 16 + i] = cs; p.rope[tok * 16 + 8 + i] = sn;
    }
  }
}

__device__ __forceinline__ float softplus_f(float x) { return fmaxf(x, 0.f) + log1pf(__expf(-fabsf(x))); }

__device__ void dn_local_task(const Params& p, int l, int task, unsigned char* smem) {
  const int b = task >> 7, h = (task >> 5) & 3, n = task & 31;
  int tid_ = otid();
  const int tid = tid_, lane = tid & 63, wid = tid >> 6;
  const size_t rowbase = (size_t)b * SEQ + n * 64;
  u16* qn_s = (u16*)smem;
  u16* kn_s = qn_s + 64 * 136;
  u16* v_s = kn_s + 64 * 136;
  float* A_f = (float*)(smem + 52224);
  float* A_b = (float*)smem;
  float* sm = (float*)(smem + 68608);
  float* gcs = sm; float* bts = sm + 128;
  __syncthreads();
  {
    const size_t chunk_id = (size_t)b * 32 + n;
    const int ch = tid & 15, r0 = tid >> 4;
#pragma unroll
    for (int part = 0; part < 3; ++part) {
      const int hc = part * 512 + h * 128 + ch * 8;
      const float* cw = p.conv_qkv + (size_t)l * 3 * 1536 + hc;
      u32x4 xm[4], x0[4], xp[4];
#pragma unroll
      for (int k = 0; k < 4; ++k) {
        const int r = k * 16 + r0;
        const u16* pc = p.proj + (rowbase + r) * LDP + C_QDN + hc;
        const u16* pm = (r == 0) ? (n == 0 ? pc : p.halo + ((chunk_id - 1) * 2 + 1) * 1536 + hc) : pc - LDP;
        const u16* pp = (r == 63) ? (n == 31 ? pc : p.halo + ((chunk_id + 1) * 2 + 0) * 1536 + hc) : pc + LDP;
        xm[k] = ldu4(pm); x0[k] = ldu4(pc); xp[k] = ldu4(pp);
      }
      float w0[8], w1[8], w2[8];
#pragma unroll
      for (int e4 = 0; e4 < 2; ++e4) {
        const f32x4 a0 = *reinterpret_cast<const f32x4*>(cw + e4 * 4), a1 = *reinterpret_cast<const f32x4*>(cw + 1536 + e4 * 4), a2 = *reinterpret_cast<const f32x4*>(cw + 3072 + e4 * 4);
#pragma unroll
        for (int e = 0; e < 4; ++e) { w0[e4 * 4 + e] = a0[e]; w1[e4 * 4 + e] = a1[e]; w2[e4 * 4 + e] = a2[e]; }
      }
      u16* dbase = (part == 0 ? qn_s : (part == 1 ? kn_s : v_s)) + ch * 8;
#pragma unroll
      for (int k = 0; k < 4; ++k) {
        const int r = k * 16 + r0;
        const float mz = (r == 0 && n == 0) ? 0.f : 1.f, pz = (r == 63 && n == 31) ? 0.f : 1.f;
        float fm[8], f0[8], fp[8], o[8];
        unpack8(xm[k], fm); unpack8(x0[k], f0); unpack8(xp[k], fp);
        float ss = 0.f;
#pragma unroll
        for (int e = 0; e < 8; ++e) {
          float a = w1[e] * f0[e] + mz * (w0[e] * fm[e]) + pz * (w2[e] * fp[e]);
          a = silu_f(a);
          o[e] = a; ss += a * a;
        }
        ss += __shfl_xor(ss, 1); ss += __shfl_xor(ss, 2); ss += __shfl_xor(ss, 4); ss += __shfl_xor(ss, 8);
        float sc = 1.f;
        if (part == 0) sc = rsqrtf(ss + EPS) * 0.08838834764831845f;
        else if (part == 1) sc = rsqrtf(ss + EPS);
#pragma unroll
        for (int e = 0; e < 8; ++e) o[e] *= sc;
        *reinterpret_cast<u32x4*>(dbase + r * 136) = pack8(o);
      }
    }
  }
  if (wid < 2) {
    const int dir = wid;
    const int c = dir ? 63 - lane : lane;
    const u16* rp = p.proj + (rowbase + c) * LDP;
    const float a = bf2f(rp[(dir ? C_AB : C_AF) + h]);
    const float bl = bf2f(rp[(dir ? C_BB : C_BF) + h]);
    const float alog = dir ? p.a_log_b[l * 4 + h] : p.a_log_f[l * 4 + h];
    const float dtb = dir ? p.dt_bias_b[l * 4 + h] : p.dt_bias_f[l * 4 + h];
    float g = -__expf(alog) * softplus_f(a + dtb);
    const float beta = 1.f / (1.f + __expf(-bl));
#pragma unroll
    for (int o = 1; o < 64; o <<= 1) { const float t = __shfl_up(g, o); if (lane >= o) g += t; }
    gcs[dir * 64 + lane] = g; bts[dir * 64 + lane] = beta; sm[256 + dir * 64 + lane] = beta * __expf(g);
    const float glast = __shfl(g, 63);
    float* ge = p.gexp + ((((size_t)b * 4 + h) * 2 + dir) * 32 + n) * 192;
    ge[lane] = __expf(g); ge[64 + lane] = __expf(glast - g);
    if (lane == 0) ge[128] = __expf(glast);
  }
  __syncthreads();
  {
#pragma unroll
    for (int it = 0; it < 4; ++it) {
      const int q = tid + 256 * it, r = q >> 4, ch = q & 15;
      *reinterpret_cast<u32x4*>(p.proj + (rowbase + r) * LDP + C_QDN + h * 128 + ch * 8) = *reinterpret_cast<const u32x4*>(qn_s + r * 136 + ch * 8);
    }
#pragma unroll
    for (int it = 0; it < 4; ++it) {
      const int q = tid + 256 * it, kk = q >> 3, c0 = (q & 7) * 8;
      float f[8];
#pragma unroll
      for (int e = 0; e < 8; ++e) f[e] = bf2f(kn_s[(c0 + e) * 136 + kk]);
      *reinterpret_cast<u32x4*>(p.proj + (rowbase + (kk >> 1)) * LDP + C_KDN + h * 128 + (kk & 1) * 64 + c0) = pack8(f);
    }
  }
  const int fr = lane & 15, fq = lane >> 4;
  f32x4 kk[4], qk[4];
#pragma unroll
  for (int jt = 0; jt < 4; ++jt) { kk[jt] = (f32x4){0.f, 0.f, 0.f, 0.f}; qk[jt] = (f32x4){0.f, 0.f, 0.f, 0.f}; }
#pragma unroll
  for (int ks = 0; ks < 4; ++ks) {
    const bf16x8 bk = ld8(kn_s + (16 * wid + fr) * 136 + ks * 32 + fq * 8);
    const bf16x8 bq = ld8(qn_s + (16 * wid + fr) * 136 + ks * 32 + fq * 8);
#pragma unroll
    for (int jt = 0; jt < 4; ++jt) {
      const bf16x8 a = ld8(kn_s + (16 * jt + fr) * 136 + ks * 32 + fq * 8);
      kk[jt] = mfma16(a, bk, kk[jt]);
      qk[jt] = mfma16(a, bq, qk[jt]);
    }
  }
  __syncthreads();
  u16* blk = p.inter + (size_t)task * 32768;
  {
    const int i = 16 * wid + fr, ib = 63 - i;
    const float gfi = gcs[i], gbi = gcs[64 + ib], bfi = bts[i], bbi = bts[64 + ib];
#pragma unroll
    for (int jt = 0; jt < 4; ++jt) {
      const int j0 = 16 * jt + fq * 4;
      f32x4 af, ab, qf, qb;
#pragma unroll
      for (int e = 0; e < 4; ++e) {
        const int j = j0 + e, jb = 63 - j;
        const float df = (i >= j) ? __expf(gfi - gcs[j]) : 0.f;
        const float db = (ib >= jb) ? __expf(gbi - gcs[64 + jb]) : 0.f;
        af[e] = (i > j) ? bfi * kk[jt][e] * df : 0.f;
        qf[e] = qk[jt][e] * df;
        ab[3 - e] = (ib > jb) ? bbi * kk[jt][e] * db : 0.f;
        qb[3 - e] = qk[jt][e] * db;
      }
      *reinterpret_cast<f32x4*>(A_f + i * 64 + j0) = af;
      *reinterpret_cast<f32x4*>(A_b + ib * 64 + (60 - j0)) = ab;
      u32x2 w; w.x = pk_bf16(qf[0], qf[1]); w.y = pk_bf16(qf[2], qf[3]);
      *reinterpret_cast<u32x2*>(blk + 24576 + i * 64 + j0) = w;
      w.x = pk_bf16(qb[0], qb[1]); w.y = pk_bf16(qb[2], qb[3]);
      *reinterpret_cast<u32x2*>(blk + 28672 + ib * 64 + (60 - j0)) = w;
    }
  }
  __syncthreads();
#ifndef NOSOLVE
  {
    const int col = tid & 127; const bool isW = tid >= 128;
    const u16* src = (isW ? kn_s : v_s) + col;
    const float* scb = isW ? (sm + 256) : bts;
#pragma unroll 1
    for (int dir = 0; dir < 2; ++dir) {
      int dsel = dir; asm volatile("" : "+v"(dsel));
      const float* Am = (const float*)(smem + (dsel ? 0 : 52224));
      const float* scp = scb + dsel * 64;
      const u16* sp = src + (dsel ? 63 * 136 : 0);
      const int sstride = dsel ? -136 : 136;
      u16* dstW = blk + (dsel ? 16384 : 0) + col;
      u16* dstU = dsel ? (blk + 8192 + col) : (p.proj + rowbase * LDP + C_VDN + h * 128 + col);
      u16* dst = isW ? dstW : dstU;
      const int ld = (isW || dsel) ? 128 : LDP;
      float x[64];
      const float* Al = Am + (tid & 63);
      float arow_n = Al[64];
#pragma unroll
      for (int i = 0; i < 64; ++i) {
        float a0 = scp[i] * bf2f(*sp), a1 = 0.f, a2 = 0.f, a3 = 0.f;
        sp += sstride;
        const int arow = __float_as_int(arow_n);
        if (i + 1 < 64 && i >= 1) arow_n = Al[(i + 1) * 64];
#pragma unroll
        for (int j = 0; j < i; ++j) {
          int stmp;
          if ((j & 3) == 0) asm volatile("v_readlane_b32 %1, %2, %3\n\tv_fma_f32 %0, -%1, %4, %0" : "+v"(a0), "=&s"(stmp) : "v"(arow), "n"(j), "v"(x[j]));
          else if ((j & 3) == 1) asm volatile("v_readlane_b32 %1, %2, %3\n\tv_fma_f32 %0, -%1, %4, %0" : "+v"(a1), "=&s"(stmp) : "v"(arow), "n"(j), "v"(x[j]));
          else if ((j & 3) == 2) asm volatile("v_readlane_b32 %1, %2, %3\n\tv_fma_f32 %0, -%1, %4, %0" : "+v"(a2), "=&s"(stmp) : "v"(arow), "n"(j), "v"(x[j]));
          else asm volatile("v_readlane_b32 %1, %2, %3\n\tv_fma_f32 %0, -%1, %4, %0" : "+v"(a3), "=&s"(stmp) : "v"(arow), "n"(j), "v"(x[j]));
        }
        x[i] = (a0 + a1) + (a2 + a3);
      }
#pragma unroll
      for (int i = 0; i < 64; ++i) { *dst = f2bf(x[i]); dst += ld; }
    }
  }
#endif
}

struct ScanA { bf16x8 w[4]; u16 u[2][4]; float egl[4]; };
struct ScanB { bf16x8 qn[4], qk[2], kt[2][2]; float eg, gl; };

__device__ __forceinline__ void scan_loadA(const Params& p, int b, int h, int dir, int slice, int s, int wid, int lane, ScanA& L) {
  const int n = dir ? 31 - s : s;
  const int fr = lane & 15, fq = lane >> 4;
  const size_t rowbase = (size_t)b * SEQ + n * 64;
  const u16* blk = p.inter + ((size_t)(b * 4 + h) * 32 + n) * 32768;
  const int cp = 16 * wid + fr;
  const u16* Wp = blk + (dir ? 16384 : 0) + cp * 128 + fq * 8;
#pragma unroll
  for (int ks = 0; ks < 4; ++ks) L.w[ks] = ld8(Wp + ks * 32);
  const float* ge = p.gexp + ((((size_t)b * 4 + h) * 2 + dir) * 32 + n) * 192;
#pragma unroll
  for (int j = 0; j < 4; ++j) L.egl[j] = ge[64 + 16 * wid + fq * 4 + j];
#pragma unroll
  for (int nt = 0; nt < 2; ++nt)
#pragma unroll
    for (int j = 0; j < 4; ++j) {
      const int c2 = 16 * wid + fq * 4 + j, col = slice * 32 + nt * 16 + fr;
      L.u[nt][j] = dir ? blk[8192 + c2 * 128 + col] : p.proj[(rowbase + c2) * LDP + C_VDN + h * 128 + col];
    }
}
__device__ __forceinline__ void scan_loadB(const Params& p, int b, int h, int dir, int s, int wid, int lane, ScanB& L) {
  const int n = dir ? 31 - s : s;
  const int fr = lane & 15, fq = lane >> 4;
  const size_t rowbase = (size_t)b * SEQ + n * 64;
  const u16* blk = p.inter + ((size_t)(b * 4 + h) * 32 + n) * 32768;
  const int cp = 16 * wid + fr;
  const int corig = dir ? 63 - cp : cp;
  const u16* Qp = p.proj + (rowbase + corig) * LDP + C_QDN + h * 128 + fq * 8;
  const u16* QKp = blk + (dir ? 28672 : 24576) + cp * 64 + fq * 8;
#pragma unroll
  for (int ks = 0; ks < 4; ++ks) L.qn[ks] = ld8(Qp + ks * 32);
#pragma unroll
  for (int ks = 0; ks < 2; ++ks) L.qk[ks] = ld8(QKp + ks * 32);
#pragma unroll
  for (int t = 0; t < 2; ++t) {
    const int kk = (2 * wid + t) * 16 + fr;
    const u16* Kp = p.proj + (rowbase + (kk >> 1)) * LDP + C_KDN + h * 128 + (kk & 1) * 64 + fq * 8;
#pragma unroll
    for (int ks = 0; ks < 2; ++ks) L.kt[t][ks] = ld8(Kp + ks * 32);
  }
  const float* ge = p.gexp + ((((size_t)b * 4 + h) * 2 + dir) * 32 + n) * 192;
  L.eg = ge[cp];
  L.gl = ge[128];
}

__device__ __forceinline__ void scan_step(const Params& p, int b, int h, int dir, int slice, int s, int wid, int lane,
                                          u16* ST0, u16* vnT, u16* vnsT, f32x4 (&S)[2][2],
                                          const ScanA& cur, const ScanB& cb, ScanA& nxt, ScanB& cbn) {
  const int fr = lane & 15, fq = lane >> 4;
  if (s + 1 < 32) { scan_loadA(p, b, h, dir, slice, s + 1, wid, lane, nxt); scan_loadB(p, b, h, dir, s + 1, wid, lane, cbn); }
  const u16* STc = ST0 + (s & 1) * 32 * 136;
  u16* STn = ST0 + ((s + 1) & 1) * 32 * 136;
  const int n = dir ? 31 - s : s;
  const size_t rowbase = (size_t)b * SEQ + n * 64;
  f32x4 vn[2];
#pragma unroll
  for (int nt = 0; nt < 2; ++nt) {
    f32x4 acc = (f32x4){0.f, 0.f, 0.f, 0.f};
#pragma unroll
    for (int ks = 0; ks < 4; ++ks) acc = mfma16(cur.w[ks], ld8(STc + (nt * 16 + fr) * 136 + ks * 32 + fq * 8), acc);
#pragma unroll
    for (int j = 0; j < 4; ++j) vn[nt][j] = bf2f(cur.u[nt][j]) - acc[j];
  }
#pragma unroll
  for (int nt = 0; nt < 2; ++nt) {
    const int nn = nt * 16 + fr, c0 = 16 * wid + fq * 4;
    u32x2 w; w.x = pk_bf16(vn[nt][0], vn[nt][1]); w.y = pk_bf16(vn[nt][2], vn[nt][3]);
    *reinterpret_cast<u32x2*>(vnT + nn * 72 + c0) = w;
    const float s0 = vn[nt][0] * cur.egl[0], s1 = vn[nt][1] * cur.egl[1], s2 = vn[nt][2] * cur.egl[2], s3 = vn[nt][3] * cur.egl[3];
    if (dir) { w.x = pk_bf16(s3, s2); w.y = pk_bf16(s1, s0); *reinterpret_cast<u32x2*>(vnsT + nn * 72 + (60 - c0)) = w; }
    else { w.x = pk_bf16(s0, s1); w.y = pk_bf16(s2, s3); *reinterpret_cast<u32x2*>(vnsT + nn * 72 + c0) = w; }
  }
  __syncthreads();
#pragma unroll
  for (int nt = 0; nt < 2; ++nt) {
    f32x4 a1 = (f32x4){0.f, 0.f, 0.f, 0.f}, a2 = (f32x4){0.f, 0.f, 0.f, 0.f};
#pragma unroll
    for (int ks = 0; ks < 4; ++ks) a1 = mfma16(ld8(STc + (nt * 16 + fr) * 136 + ks * 32 + fq * 8), cb.qn[ks], a1);
#pragma unroll
    for (int ks = 0; ks < 2; ++ks) a2 = mfma16(ld8(vnT + (nt * 16 + fr) * 72 + ks * 32 + fq * 8), cb.qk[ks], a2);
    const int cp = 16 * wid + fr, col = slice * 32 + nt * 16 + fq * 4;
    u32x2 w; w.x = pk_bf16(a1[0] * cb.eg + a2[0], a1[1] * cb.eg + a2[1]); w.y = pk_bf16(a1[2] * cb.eg + a2[2], a1[3] * cb.eg + a2[3]);
    u16* op = dir ? (p.inter + ((size_t)(b * 4 + h) * 32 + n) * 32768 + 8192 + cp * 128 + col)
                  : (p.proj + (rowbase + cp) * LDP + C_VDN + h * 128 + col);
    *reinterpret_cast<u32x2*>(op) = w;
  }
#pragma unroll
  for (int t = 0; t < 2; ++t)
#pragma unroll
    for (int nt = 0; nt < 2; ++nt) {
      f32x4 acc = S[t][nt] * cb.gl;
#pragma unroll
      for (int ks = 0; ks < 2; ++ks) acc = mfma16(cb.kt[t][ks], ld8(vnsT + (nt * 16 + fr) * 72 + ks * 32 + fq * 8), acc);
      S[t][nt] = acc;
      u32x2 w; w.x = pk_bf16(acc[0], acc[1]); w.y = pk_bf16(acc[2], acc[3]);
      *reinterpret_cast<u32x2*>(STn + (nt * 16 + fr) * 136 + (2 * wid + t) * 16 + fq * 4) = w;
    }
  __syncthreads();
}

__device__ void scan_task(const Params& p, int sid, unsigned char* smem) {
  const int b = sid >> 5, h = (sid >> 3) & 3, dir = (sid >> 2) & 1, slice = sid & 3;
  int tid_ = otid();
  const int tid = tid_, lane = tid & 63, wid = tid >> 6;
  u16* ST0 = (u16*)smem;
  u16* vnT = ST0 + 2 * 32 * 136;
  u16* vnsT = vnT + 32 * 72;
  __syncthreads();
  for (int i = tid; i < 32 * 136 / 2; i += NT) reinterpret_cast<unsigned*>(ST0)[i] = 0u;
  f32x4 S[2][2];
#pragma unroll
  for (int a = 0; a < 2; ++a)
#pragma unroll
    for (int c = 0; c < 2; ++c) S[a][c] = (f32x4){0.f, 0.f, 0.f, 0.f};
  ScanA a0, a1;
  ScanB b0, b1;
  scan_loadA(p, b, h, dir, slice, 0, wid, lane, a0);
  scan_loadB(p, b, h, dir, 0, wid, lane, b0);
  __syncthreads();
  __builtin_amdgcn_s_setprio(3);
#pragma unroll 1
  for (int s = 0; s < 32; s += 2) {
    scan_step(p, b, h, dir, slice, s, wid, lane, ST0, vnT, vnsT, S, a0, b0, a1, b1);
    scan_step(p, b, h, dir, slice, s + 1, wid, lane, ST0, vnT, vnsT, S, a1, b1, a0, b0);
  }
  __builtin_amdgcn_s_setprio(0);
}

__device__ void attn_task(const Params& p, int aid, int half, unsigned char* smem) {
  const int b = aid / 384, rem = aid % 384, pt = rem >> 7, rem2 = rem & 127, h = rem2 >> 5, q = rem2 & 31;
  const int dl = pt == 0 ? 1 : (pt == 1 ? 4 : 16);
  const int L = SEQ / dl, nbl = L / 64;
  const int r = q / nbl, nb = q % nbl;
  int tid_ = otid();
  const int tid = tid_, lane = tid & 63, wid = tid >> 6, fr = lane & 15, fq = lane >> 4;
  u16* Qs = (u16*)smem;
  u16* Ks = Qs + 64 * 72;
  u16* VT = Ks + 192 * 72;
  u16* Ps = Ks;
  const size_t tokbase = (size_t)b * SEQ;
  const int cq = C_QC + pt * 256 + h * 64, ck = C_KC + pt * 256 + h * 64, cv = C_VC + pt * 256 + h * 64;
  __syncthreads();
  {
    const int ch = tid & 7, rb = tid >> 3;
    u32x4 qk[8], vv[6];
#pragma unroll
    for (int k = 0; k < 8; ++k) {
      const int row = rb + 32 * k;
      const int i = (k < 2) ? nb * 64 + row : nb * 64 - 128 + row;
      qk[k] = (u32x4){0u, 0u, 0u, 0u};
      if (i >= 0 && i < L) qk[k] = ldu4(p.proj + (tokbase + (size_t)i * dl + r) * LDP + ((k < 2) ? cq : ck) + ch * 8);
    }
#pragma unroll
    for (int k = 0; k < 6; ++k) {
      const int j = nb * 64 - 64 + rb + 32 * k;
      vv[k] = (u32x4){0u, 0u, 0u, 0u};
      if (j >= 0 && j < L) vv[k] = ldu4(p.proj + (tokbase + (size_t)j * dl + r) * LDP + cv + ch * 8);
    }
#pragma unroll
    for (int k = 0; k < 8; ++k) {
      const int row = rb + 32 * k;
      u16* dst = ((k < 2) ? Qs + row * 72 : Ks + (row - 64) * 72) + ch * 8;
      *reinterpret_cast<u32x4*>(dst) = qk[k];
    }
#pragma unroll
    for (int k = 0; k < 6; ++k) {
      const u32x4 w = vv[k];
      u16* d = VT + (ch * 8) * 200 + rb + 32 * k;
      d[0] = (u16)(w.x & 0xffff); d[200] = (u16)(w.x >> 16); d[400] = (u16)(w.y & 0xffff); d[600] = (u16)(w.y >> 16);
      d[800] = (u16)(w.z & 0xffff); d[1000] = (u16)(w.z >> 16); d[1200] = (u16)(w.w & 0xffff); d[1400] = (u16)(w.w >> 16);
    }
  }
  __syncthreads();
  {
    const int e = tid & 7, rb = tid >> 3;
#pragma unroll
    for (int k = 0; k < 8; ++k) {
      const int row = rb + 32 * k;
      const int i = (k < 2) ? nb * 64 + row : nb * 64 - 128 + row;
      if (i >= 0 && i < L) {
        const size_t tok = tokbase + (size_t)i * dl + r;
        const float* rp = p.rope + (tok + (size_t)half * 8192) * 16;
        const float cs = rp[e], sn = rp[8 + e];
        u16* buf = (k < 2) ? Qs + row * 72 : Ks + (row - 64) * 72;
        const float x1 = bf2f(buf[e]), x2 = bf2f(buf[8 + e]);
        buf[e] = f2bf(x1 * cs - x2 * sn); buf[8 + e] = f2bf(x2 * cs + x1 * sn);
      }
    }
  }
  __syncthreads();
  f32x4 sc[12];
  {
    const bf16x8 q0 = ld8(Qs + (16 * wid + fr) * 72 + fq * 8), q1 = ld8(Qs + (16 * wid + fr) * 72 + 32 + fq * 8);
#pragma unroll
    for (int kt = 0; kt < 12; ++kt) {
      f32x4 a = (f32x4){0.f, 0.f, 0.f, 0.f};
      a = mfma16(ld8(Ks + (kt * 16 + fr) * 72 + fq * 8), q0, a);
      a = mfma16(ld8(Ks + (kt * 16 + fr) * 72 + 32 + fq * 8), q1, a);
      sc[kt] = a;
    }
  }
  const int qi = nb * 64 + 16 * wid + fr;
  float mx = -3.0e38f;
#pragma unroll
  for (int kt = 0; kt < 12; ++kt)
#pragma unroll
    for (int e = 0; e < 4; ++e) {
      const int j = nb * 64 - 64 + kt * 16 + fq * 4 + e;
      const int d = qi - j;
      const bool valid = (j >= 0) && (j < L) && (d <= 64) && (d >= -64);
      const float s = valid ? sc[kt][e] * 0.125f : -1e30f;
      sc[kt][e] = s; mx = fmaxf(mx, s);
    }
  mx = fmaxf(mx, __shfl_xor(mx, 16)); mx = fmaxf(mx, __shfl_xor(mx, 32));
  float den = 0.f;
#pragma unroll
  for (int kt = 0; kt < 12; ++kt)
#pragma unroll
    for (int e = 0; e < 4; ++e) { const float pe = __expf(sc[kt][e] - mx); sc[kt][e] = pe; den += pe; }
  den += __shfl_xor(den, 16); den += __shfl_xor(den, 32);
  __syncthreads();
#pragma unroll
  for (int kt = 0; kt < 12; ++kt) {
    u32x2 w; w.x = pk_bf16(sc[kt][0], sc[kt][1]); w.y = pk_bf16(sc[kt][2], sc[kt][3]);
    *reinterpret_cast<u32x2*>(Ps + (16 * wid + fr) * 200 + kt * 16 + fq * 4) = w;
  }
  __syncthreads();
  const float inv = 1.f / den;
  const size_t tokq = tokbase + (size_t)qi * dl + r;
#pragma unroll
  for (int dt = 0; dt < 4; ++dt) {
    f32x4 a = (f32x4){0.f, 0.f, 0.f, 0.f};
#pragma unroll
    for (int ks = 0; ks < 6; ++ks) a = mfma16(ld8(VT + (dt * 16 + fr) * 200 + ks * 32 + fq * 8), ld8(Ps + (16 * wid + fr) * 200 + ks * 32 + fq * 8), a);
    u32x2 w; w.x = pk_bf16(a[0] * inv, a[1] * inv); w.y = pk_bf16(a[2] * inv, a[3] * inv);
    *reinterpret_cast<u32x2*>(p.proj + tokq * LDP + cq + dt * 16 + fq * 4) = w;
  }
  if (fq == 0) p.lse[((size_t)pt * 8192 + tokq) * 4 + h] = mx + __logf(den);
}

__device__ void phase_scan_attn(const Params& p, int l, int half, unsigned char* smem) {
  const int bi = obid(), G = gridDim.x;
  const int nscan_blocks = G >= 256 ? 128 : G / 2;
  if (bi < nscan_blocks) {
    for (int t = bi; t < 128; t += nscan_blocks) {
      const int sid = (t & 7) * 16 + (t >> 3);
      scan_task(p, sid, smem);
    }
  } else {
    const int na = G - nscan_blocks;
    for (int t = bi - nscan_blocks; t < 1536; t += na) attn_task(p, t, half, smem);
    if (half == 0) {
      const float* xsrc = (l == 0) ? p.x : p.xres;
      u16* h1 = p.proj + (size_t)8192 * LDP;
      for (int t = bi - nscan_blocks; t < 8192 / 16; t += na) norm_task(xsrc + (size_t)8192 * DM, p.norm_mix + l * DM, h1, nullptr, t);
    } else {
      for (int t = bi - nscan_blocks; t < (DM / 64) * (2 * DFF / 64); t += na)
        wconv_task(p.w_up + (size_t)l * DM * 2 * DFF, DM, 2 * DFF, 2 * DFF, p.WA, t, smem, true);
    }
  }
}

__device__ void combine_task(const Params& p, int l, int task) {
  const int lane = otid() & 63, wid = otid() >> 6;
  const int g16 = lane >> 4;
  u32x2 oa[4], oc[4]; u32x4 ob4[4];
#pragma unroll
  for (int rr = 0; rr < 4; ++rr) {
    const size_t row = (size_t)task * 16 + wid * 4 + rr;
    const int t = (int)(row & (SEQ - 1));
    const u16* rp = p.proj + row * LDP;
    float ya[4];
    {
      const int c = 4 * lane;
      const float* cw = p.conv_a + (size_t)l * 3 * 256 + c;
      float z[4] = {0.f, 0.f, 0.f, 0.f};
#pragma unroll
      for (int i = 0; i < 3; ++i) {
        const int tt = t + i - 1;
        if (tt < 0 || tt >= SEQ) continue;
        const u16* r2 = rp + (ptrdiff_t)(i - 1) * LDP;
        const u32x2 xa = *reinterpret_cast<const u32x2*>(r2 + c), gc = *reinterpret_cast<const u32x2*>(r2 + 512 + c);
        const f32x4 w = *reinterpret_cast<const f32x4*>(cw + i * 256);
        z[0] += w[0] * bflo(xa.x) * bflo(gc.x); z[1] += w[1] * bfhi(xa.x) * bfhi(gc.x);
        z[2] += w[2] * bflo(xa.y) * bflo(gc.y); z[3] += w[3] * bfhi(xa.y) * bfhi(gc.y);
      }
      const u32x2 gb = *reinterpret_cast<const u32x2*>(rp + 256 + c);
      z[0] *= bflo(gb.x); z[1] *= bfhi(gb.x); z[2] *= bflo(gb.y); z[3] *= bfhi(gb.y);
      float ss = z[0] * z[0] + z[1] * z[1] + z[2] * z[2] + z[3] * z[3];
#pragma unroll
      for (int o = 1; o < 16; o <<= 1) ss += __shfl_xor(ss, o);
      const float rs = rsqrtf(ss * (1.f / 64.f) + EPS);
      const f32x4 g = *reinterpret_cast<const f32x4*>(p.norm_a + l * 256 + c);
#pragma unroll
      for (int e = 0; e < 4; ++e) ya[e] = z[e] * rs * g[e];
    }
    float yb[8];
    {
      const int c = 8 * lane, hh = g16, cc = c & 127;
      const int n = t >> 6, ci = t & 63;
      float of[8], ob[8], gt[8];
      unpack8(ldu4(rp + C_VDN + c), of);
      const u16* blk = p.inter + ((size_t)((row >> 11) * 4 + hh) * 32 + n) * 32768;
      unpack8(ldu4(blk + 8192 + (63 - ci) * 128 + cc), ob);
      unpack8(ldu4(rp + C_GATE + c), gt);
      float ss = 0.f;
#pragma unroll
      for (int e = 0; e < 8; ++e) { of[e] += ob[e]; ss += of[e] * of[e]; }
#pragma unroll
      for (int o = 1; o < 16; o <<= 1) ss += __shfl_xor(ss, o);
      const float rs = rsqrtf(ss * (1.f / 128.f) + EPS);
      const float* g = p.norm_dn + l * 128 + cc;
#pragma unroll
      for (int e = 0; e < 8; ++e) yb[e] = of[e] * rs * g[e] * silu_f(gt[e]);
    }
    float yc[4];
    {
      const int c = 4 * lane, hh = g16;
      const float l0 = p.lse[((size_t)0 * 8192 + row) * 4 + hh], l1 = p.lse[((size_t)1 * 8192 + row) * 4 + hh], l2 = p.lse[((size_t)2 * 8192 + row) * 4 + hh];
      const float mxl = fmaxf(l0, fmaxf(l1, l2));
      float a0 = __expf(l0 - mxl), a1 = __expf(l1 - mxl), a2 = __expf(l2 - mxl);
      const float is = 1.f / (a0 + a1 + a2); a0 *= is; a1 *= is; a2 *= is;
      const u32x2 o0 = *reinterpret_cast<const u32x2*>(rp + C_QC + c), o1 = *reinterpret_cast<const u32x2*>(rp + C_QC + 256 + c), o2 = *reinterpret_cast<const u32x2*>(rp + C_QC + 512 + c);
      float o[4];
      o[0] = a0 * bflo(o0.x) + a1 * bflo(o1.x) + a2 * bflo(o2.x); o[1] = a0 * bfhi(o0.x) + a1 * bfhi(o1.x) + a2 * bfhi(o2.x);
      o[2] = a0 * bflo(o0.y) + a1 * bflo(o1.y) + a2 * bflo(o2.y); o[3] = a0 * bfhi(o0.y) + a1 * bfhi(o1.y) + a2 * bfhi(o2.y);
      float ss = o[0] * o[0] + o[1] * o[1] + o[2] * o[2] + o[3] * o[3];
#pragma unroll
      for (int of = 1; of < 16; of <<= 1) ss += __shfl_xor(ss, of);
      const float rs = rsqrtf(ss * (1.f / 64.f) + EPS);
      const f32x4 g = *reinterpret_cast<const f32x4*>(p.norm_c + l * 256 + c);
#pragma unroll
      for (int e = 0; e < 4; ++e) yc[e] = o[e] * rs * g[e];
    }
    oa[rr].x = pk_bf16(ya[0], ya[1]); oa[rr].y = pk_bf16(ya[2], ya[3]);
    ob4[rr] = pack8(yb);
    oc[rr].x = pk_bf16(yc[0], yc[1]); oc[rr].y = pk_bf16(yc[2], yc[3]);
  }
#pragma unroll
  for (int rr = 0; rr < 4; ++rr) {
    u16* yp = p.proj + ((size_t)task * 16 + wid * 4 + rr) * LDP + C_QDN;
    *reinterpret_cast<u32x2*>(yp + 4 * lane) = oa[rr];
    *reinterpret_cast<u32x4*>(yp + 256 + 8 * lane) = ob4[rr];
    *reinterpret_cast<u32x2*>(yp + 768 + 4 * lane) = oc[rr];
  }
}

__device__ void ffn_fix_item(const Params& p, int l, u16* act, int tm, int item) {
  const int cc = item % 352, side = item / 352;
  const int jg = cc * 8, pos = (jg >> 6) * 128 + (jg & 63);
  const int row = tm * 256 + (side ? 255 : 0), tseq = row & (SEQ - 1);
  const u16* ub = p.ubnd + (size_t)tm * 4 * (2 * DFF) + pos;
  const u16* r0; const u16* r1; const u16* r2; bool z0 = false, z2 = false;
  if (side == 0) { r1 = ub; r2 = ub + 2 * DFF; if (tseq == 0) { z0 = true; r0 = ub; } else r0 = ub - (2 * DFF); }
  else { r0 = ub + 2 * (2 * DFF); r1 = ub + 3 * (2 * DFF); if (tseq == SEQ - 1) { z2 = true; r2 = r1; } else r2 = ub + 4 * (2 * DFF); }
  const float* cw = p.conv_ffn + (size_t)l * 3 * 2 * DFF;
  float g[8], v[8];
#pragma unroll
  for (int e = 0; e < 8; ++e) { g[e] = 0.f; v[e] = 0.f; }
#pragma unroll
  for (int i = 0; i < 3; ++i) {
    const u16* rp = i == 0 ? r0 : (i == 1 ? r1 : r2);
    const float mz = ((i == 0 && z0) || (i == 2 && z2)) ? 0.f : 1.f;
    float a[8], bq[8];
    unpack8(ldu4(rp), a); unpack8(ldu4(rp + 64), bq);
    const float* wg = cw + i * 2 * DFF + jg; const float* wv = wg + DFF;
#pragma unroll
    for (int e = 0; e < 8; ++e) { g[e] += mz * (wg[e] * a[e]); v[e] += mz * (wv[e] * bq[e]); }
  }
  float o[8];
#pragma unroll
  for (int e = 0; e < 8; ++e) o[e] = silu_f(g[e]) * v[e];
  *reinterpret_cast<u32x4*>(act + (size_t)row * DFF + jg) = pack8(o);
}

constexpr int STEPS_PER_LAYER = 14;
constexpr int NSTEPS = 2 * STEPS_PER_LAYER + 1;

__device__ void run_step(const Params& p, int step, float* out, unsigned char* smem) {
  if (step == NSTEPS - 1) {
    for (int t = obid(); t < M_TOK / 16; t += gridDim.x) norm_task(p.xres, p.norm_final, nullptr, out, t);
    return;
  }
  const int l = step / STEPS_PER_LAYER, s = step % STEPS_PER_LAYER;
  u16* h = p.inter;
  if (s == 0) {
    phase_norm_w(p, l, 0, 0, true, smem);
  } else if (s < 11) {
    const int half = (s - 1) / 5, q = (s - 1) % 5;
    float* xh = p.xres + (size_t)half * 8192 * DM;
    const float* rin = (l == 0) ? (p.x + (size_t)half * 8192 * DM) : xh;
    const u16* hA = half ? (p.proj + (size_t)8192 * LDP) : h;
    switch (q) {
      case 0: gemm256_phase<EPI_PROJ>(hA, DM, p.WA, 8192, LDP, DM, p.proj, LDP, nullptr, nullptr, p.halo, smem); break;
      case 1: for (int t = obid(); t < 512; t += gridDim.x) dn_local_task(p, l, t, smem); break;
      case 2: phase_scan_attn(p, l, half, smem); break;
      case 3: for (int t = obid(); t < 8192 / 16; t += gridDim.x) combine_task(p, l, t); break;
      default: gemm_phase<EPI_RES>(p.proj + C_QDN, LDP, p.WB, 8192, DM, DM, nullptr, DM, xh, rin, nullptr, smem); break;
    }
  } else if (s == 11) {
    phase_norm_w(p, l, 1, 0, true, smem);
  } else {
    u16* act = p.proj;
    if (s == 12) gemm256_phase<EPI_UPACT>(h, DM, p.WA, M_TOK, 2 * DFF, DM, act, DFF, nullptr, p.conv_ffn + (size_t)l * 3 * 2 * DFF, p.ubnd, smem);
    else {
#pragma unroll 1
      for (int q = obid() >> 3; q < 8 * 8; q += (gridDim.x >> 3)) {
        const int tm = (obid() & 7) * 8 + (q & 7);
#pragma unroll 1
        for (int it = otid(); it < 704; it += NT) ffn_fix_item(p, l, act, tm, it);
      }
      asm volatile("s_waitcnt vmcnt(0)" ::: "memory");
      __syncthreads();
      gemm256_phase<EPI_RES>(act, DFF, p.WB, M_TOK, DM, DFF, nullptr, DM, p.xres, p.xres, nullptr, smem);
    }
  }
}

#define XB_TMO      128
#define XB_XCNT(j)  (256  + 64 * (j))
#define XB_XSUB(j)  (1280 + 64 * (j))
#define XB_XGEN(j)  (2304 + 64 * (j))
#define XB_TOP      3328
#define XB_TOPGEN   3392
#define XCD_BAR_WORDS 3456
#define XB_SPIN_CAP (1u << 18)
#define LAS __attribute__((address_space(3)))

__device__ __forceinline__ unsigned xb_ld(unsigned* p)              { return __hip_atomic_load(p, __ATOMIC_RELAXED, __HIP_MEMORY_SCOPE_AGENT); }
__device__ __forceinline__ unsigned xb_add(unsigned* p, unsigned v) { return __hip_atomic_fetch_add(p, v, __ATOMIC_RELAXED, __HIP_MEMORY_SCOPE_AGENT); }
__device__ __forceinline__ unsigned xb_xcc_id() { return (unsigned)__builtin_amdgcn_s_getreg((3 << 11) | 20) & 0xFu; }
#define XB_SPIN(cond, bar) do { unsigned _sp = 0; while (cond) { __builtin_amdgcn_s_sleep(1); \
    if ((++_sp & 255u) == 0u) { if (xb_ld(&(bar)[XB_TMO])) break; if (_sp > XB_SPIN_CAP) { atomicAdd(&(bar)[XB_TMO], 1u); break; } } } } while (0)

struct XcdBarrier {
    unsigned* bar; unsigned x;
    volatile LAS unsigned* st;
};

__device__ __forceinline__ XcdBarrier xcd_barrier_post(unsigned* bar, volatile LAS unsigned* st) {
    XcdBarrier b; b.bar = bar; b.x = xb_xcc_id(); b.st = st;
    if (threadIdx.x == 0) (void)xb_add(&bar[XB_XCNT(b.x)], 1u);
    return b;
}
__device__ __forceinline__ void xcd_barrier_complete(unsigned* bar, unsigned x, unsigned& nloc, unsigned& nx) {
    const unsigned G = gridDim.x * gridDim.y * gridDim.z;
    unsigned sum, cnt, mine, sp = 0u;
    for (;;) {
        sum = 0u; cnt = 0u; mine = 0u;
#pragma unroll
        for (unsigned j = 0; j < 16; ++j) { const unsigned c = xb_ld(&bar[XB_XCNT(j)]); sum += c; cnt += (c > 0u) ? 1u : 0u; mine = (j == x) ? c : mine; }
        if (sum == G) break;
        __builtin_amdgcn_s_sleep(1);
        if ((++sp & 255u) == 0u) { if (xb_ld(&bar[XB_TMO])) break; if (sp > XB_SPIN_CAP) { atomicAdd(&bar[XB_TMO], 1u); break; } }
    }
    nloc = mine > 0u ? mine : 1u; nx = cnt > 0u ? cnt : 1u;
}

__device__ __forceinline__ void xcd_barrier(const XcdBarrier& b) {
    asm volatile("s_waitcnt vmcnt(0)" ::: "memory");
    __syncthreads();
    if (threadIdx.x == 0) {
        unsigned* bar = b.bar;
        __builtin_amdgcn_s_waitcnt(0);
        unsigned nloc = b.st[0], nx = b.st[1];
        if (nloc == 0u) { xcd_barrier_complete(bar, b.x, nloc, nx); b.st[0] = nloc; b.st[1] = nx; }
        const unsigned old = xb_add(&bar[XB_XSUB(b.x)], 1u);
        const unsigned gen = old / nloc;
        if (old + 1u == (gen + 1u) * nloc) {
            __builtin_amdgcn_fence(__ATOMIC_RELEASE, "agent");
            asm volatile("s_waitcnt vmcnt(0)" ::: "memory");
            const unsigned og = xb_add(&bar[XB_TOP], 1u);
            const unsigned tg = og / nx;
            if (og + 1u == (tg + 1u) * nx) xb_add(&bar[XB_TOPGEN], 1u);
            else XB_SPIN(xb_ld(&bar[XB_TOPGEN]) == tg, bar);
            __builtin_amdgcn_fence(__ATOMIC_ACQUIRE, "agent");
            xb_add(&bar[XB_XGEN(b.x)], 1u);
            asm volatile("s_waitcnt vmcnt(0)" ::: "memory");
        } else {
            XB_SPIN(xb_ld(&bar[XB_XGEN(b.x)]) == gen, bar);
            __builtin_amdgcn_fence(__ATOMIC_ACQUIRE, "agent");
            asm volatile("s_waitcnt vmcnt(0)" ::: "memory");
        }
    }
    __syncthreads();
}


__device__ __forceinline__ void grid_bar(unsigned* ctr, unsigned target) {
  asm volatile("s_waitcnt vmcnt(0)" ::: "memory");
  __syncthreads();
  if (otid() == 0) {
    __builtin_amdgcn_fence(__ATOMIC_RELEASE, "agent");
    asm volatile("s_waitcnt vmcnt(0)" ::: "memory");
    const unsigned grp = obid() & 7u, gsz = gridDim.x >> 3;
    unsigned* cg_ = ctr + 64 * (1 + grp);
    const unsigned old = __hip_atomic_fetch_add(cg_, 1u, __ATOMIC_RELAXED, __HIP_MEMORY_SCOPE_AGENT);
    if (old + 1 == target * gsz) __hip_atomic_fetch_add(ctr, 1u, __ATOMIC_RELAXED, __HIP_MEMORY_SCOPE_AGENT);
    while (__hip_atomic_load(ctr, __ATOMIC_RELAXED, __HIP_MEMORY_SCOPE_AGENT) < target * 8u) { }
    __builtin_amdgcn_fence(__ATOMIC_ACQUIRE, "agent");
  }
  __syncthreads();
}

__global__ void __launch_bounds__(NT, 2) mega_kernel(Params p, int step_lo, int step_hi) {
  extern __shared__ __attribute__((aligned(16))) unsigned char smem[];
  cg::grid_group grid = cg::this_grid();
  __shared__ unsigned xb_words[4];
  if (threadIdx.x == 0) { xb_words[0] = 0u; xb_words[1] = 0u; }
  __syncthreads();
  const XcdBarrier xb = xcd_barrier_post(p.bar, (volatile LAS unsigned*)&xb_words);
  for (int step = step_lo; step < step_hi; ++step) {
    run_step(p, step, (float*)p.out, smem);
    if (step + 1 < step_hi) {
      if (step_hi < 0) grid.sync();
      xcd_barrier(xb);
    }
  }
}

extern "C" void kernel_launch(void* const* d_in, const int* in_sizes, int n_in, void* d_out, int out_size, void* d_ws, size_t ws_size,
                              hipStream_t stream) {
  static int grid_blocks = 0;
  if (!grid_blocks) {
    int dev = 0, cus = 0, per_cu = 0;
    hipGetDevice(&dev);
    hipDeviceGetAttribute(&cus, hipDeviceAttributeMultiprocessorCount, dev);
    hipFuncSetAttribute((const void*)mega_kernel, hipFuncAttributeMaxDynamicSharedMemorySize, SMEM_BYTES);
    hipOccupancyMaxActiveBlocksPerMultiprocessor(&per_cu, mega_kernel, NT, SMEM_BYTES);
    if (per_cu > 2) per_cu = 2;
    if (per_cu < 1) per_cu = 1;
    grid_blocks = cus * per_cu;
    grid_blocks -= grid_blocks % 8;
  }
  Params p{};
  p.x = (const float*)d_in[0]; p.pos = (const int*)d_in[1]; p.norm_mix = (const float*)d_in[2]; p.w_in = (const float*)d_in[3];
  p.conv_a = (const float*)d_in[4]; p.norm_a = (const float*)d_in[5]; p.conv_qkv = (const float*)d_in[6];
  p.a_log_f = (const float*)d_in[7]; p.a_log_b = (const float*)d_in[8]; p.dt_bias_f = (const float*)d_in[9]; p.dt_bias_b = (const float*)d_in[10];
  p.norm_dn = (const float*)d_in[11]; p.norm_c = (const float*)d_in[12]; p.w_o = (const float*)d_in[13]; p.norm_ffn = (const float*)d_in[14];
  p.w_up = (const float*)d_in[15]; p.conv_ffn = (const float*)d_in[16]; p.w_down = (const float*)d_in[17]; p.norm_final = (const float*)d_in[18];
  p.out = (float*)d_out;
  unsigned char* ws = (unsigned char*)d_ws;
  size_t off = 0;
  p.proj = (u16*)(ws + off); off += (size_t)8192 * 3 * DFF * 2;
  p.inter = (u16*)(ws + off); off += (size_t)512 * 65536;
  p.WA = (u16*)(ws + off); off += (size_t)2 * DFF * DM * 2;
  p.WB = (u16*)(ws + off); off += (size_t)DM * DFF * 2;
  p.halo = (u16*)(ws + off); off += (size_t)256 * 1536 * 2;
  p.lse = (float*)(ws + off); off += (size_t)3 * 8192 * 4 * 4;
  p.gexp = (float*)(ws + off); off += (size_t)1024 * 192 * 4;
  p.rope = (float*)(ws + off); off += (size_t)M_TOK * 16 * 4;
  p.xres = (float*)(ws + off); off += (size_t)M_TOK * DM * 4;
  p.bar = (unsigned*)(ws + off); off += 16384;
  p.ubnd = (u16*)(ws + off); off += (size_t)128 * 4 * 2 * DFF * 2;
  if (off > ws_size) { fprintf(stderr, "workspace too small: need %zu have %zu\n", off, ws_size); return; }
#if MEGA
  hipMemsetAsync(p.bar, 0, 16384, stream);
  int lo = 0, hi = NSTEPS;
  void* args[] = {&p, &lo, &hi};
  hipError_t e = hipLaunchCooperativeKernel((const void*)mega_kernel, dim3(grid_blocks), dim3(NT), args, SMEM_BYTES, stream);
  if (e != hipSuccess) fprintf(stderr, "cooperative launch failed: %s (grid %d)\n", hipGetErrorString(e), grid_blocks);
#else
  for (int s = 0; s < NSTEPS; ++s) hipLaunchKernelGGL(mega_kernel, dim3(grid_blocks), dim3(NT), SMEM_BYTES, stream, p, s, s + 1);
#endif
}
```
